# Optimizing an MI355X kernel written in HIP

```python
import jax, jax.numpy as jnp
from jax import lax
import numpy as np

D_MODEL = 2048
BATCH = 16
SEQ = 2048
DEPTH = 2

N_MIXERS = 2
N_META = 16
D_FF = 5632
FFN_HALF = 0.5
NORM_EPS = 1e-6
ROPE_THETA = 500000.0
ROPE_FRAC = 4
M_HEADS = 4
M_DQK = D_MODEL // (2 * M_HEADS)
M_DV = D_MODEL // M_HEADS
M_CHUNK = 64
LOG_I_PAD = -1e30
A_HEADS = 16
A_KV_HEADS = 4
A_HEAD_DIM = D_MODEL // A_HEADS
IDX_HEADS = 16
IDX_DIM = 64
TOPK_MAX = 256
SPARSE_Q_BLOCK = 64

M_IN = 2 * M_HEADS * M_DQK + 2 * M_HEADS * M_DV + 2 * M_HEADS
A_IN = A_HEADS * A_HEAD_DIM + 2 * A_KV_HEADS * A_HEAD_DIM + IDX_HEADS * IDX_DIM + IDX_DIM + IDX_HEADS
N_A = (DEPTH + 1) // 2
N_B = DEPTH // 2

kernel_name = "hybrid_mlstm_dsa_macaron_meta"


def rmsnorm(x, g):
    xf = x.astype(jnp.float32)
    y = xf * lax.rsqrt(jnp.mean(xf * xf, axis=-1, keepdims=True) + NORM_EPS)
    return (y * g.astype(jnp.float32)).astype(x.dtype)


def swiglu(x, w_gate, w_up, w_down):
    return (jax.nn.silu(x @ w_gate) * (x @ w_up)) @ w_down


def rope_partial(x, pos):
    d = x.shape[-1]
    rot = d // ROPE_FRAC
    half = rot // 2
    inv = 1.0 / (ROPE_THETA ** (jnp.arange(0, rot, 2, dtype=jnp.float32) / rot))
    ang = pos[:, None] * inv[None, :]
    cos = jnp.cos(ang)[:, None, :]
    sin = jnp.sin(ang)[:, None, :]
    xf = x.astype(jnp.float32)
    x1 = xf[..., :half]
    x2 = xf[..., half:rot]
    out = jnp.concatenate([x1 * cos - x2 * sin, x2 * cos + x1 * sin, xf[..., rot:]], axis=-1)
    return out.astype(x.dtype)


def mlstm_mixer(u, w_in, b_i, b_f, g_head, w_out):
    B, T, _ = u.shape
    H, DK, DV = M_HEADS, M_DQK, M_DV
    f32 = jnp.float32
    p = u @ w_in
    cuts = np.cumsum([H * DK, H * DK, H * DV, H * DV, H]).tolist()
    q, k, v, o, ig, fg = jnp.split(p, cuts, axis=-1)

    def heads(a, d):
        return a.reshape(B, T, H, d).transpose(0, 2, 1, 3).astype(f32)

    q = heads(q, DK) * (DK ** -0.5)
    k = heads(k, DK)
    v = heads(v, DV)
    log_i = (ig.astype(f32) + b_i.astype(f32)).transpose(0, 2, 1)
    log_f = jax.nn.log_sigmoid(fg.astype(f32) + b_f.astype(f32)).transpose(0, 2, 1)

    pad = (-N_META) % M_CHUNK
    pw = ((0, 0), (0, 0), (pad, 0), (0, 0))
    q = jnp.pad(q, pw)
    k = jnp.pad(k, pw)
    v = jnp.pad(v, pw)
    log_i = jnp.pad(log_i, pw[:3], constant_values=LOG_I_PAD)
    log_f = jnp.pad(log_f, pw[:3])
    Tp = T + pad
    L = M_CHUNK
    NC = Tp // L

    def chunks(a):
        return jnp.moveaxis(a.reshape(B, H, NC, L, *a.shape[3:]), 2, 0)

    causal = jnp.tril(jnp.ones((L, L), dtype=bool))

    def step(carry, xs):
        C, n, m = carry
        qc, kc, vc, li, lf = xs
        b = jnp.cumsum(lf, axis=-1)
        Dm = jnp.where(causal, b[..., :, None] - b[..., None, :] + li[..., None, :], -jnp.inf)
        inter = b + m[..., None]
        m_t = jnp.maximum(inter, jnp.max(Dm, axis=-1))
        s = jnp.einsum('bhld,bhsd->bhls', qc, kc) * jnp.exp(Dm - m_t[..., None])
        w_inter = jnp.exp(inter - m_t)
        num = w_inter[..., None] * jnp.einsum('bhld,bhde->bhle', qc, C) + jnp.einsum('bhls,bhse->bhle', s, vc)
        den = w_inter * jnp.einsum('bhld,bhd->bhl', qc, n) + jnp.sum(s, axis=-1)
        h_out = num / jnp.maximum(jnp.abs(den), jnp.exp(-m_t))[..., None]
        bL = b[..., -1]
        g = bL[..., None] - b + li
        m_new = jnp.maximum(bL + m, jnp.max(g, axis=-1))
        decay = jnp.exp(bL + m - m_new)
        wk = jnp.exp(g - m_new[..., None])
        C_new = decay[..., None, None] * C + jnp.einsum('bhld,bhle->bhde', kc * wk[..., None], vc)
        n_new = decay[..., None] * n + jnp.einsum('bhl,bhld->bhd', wk, kc)
        return (C_new, n_new, m_new), h_out

    init = (jnp.zeros((B, H, DK, DV), f32), jnp.zeros((B, H, DK), f32), jnp.zeros((B, H), f32))
    _, hs = lax.scan(step, init, (chunks(q), chunks(k), chunks(v), chunks(log_i), chunks(log_f)))
    hs = jnp.moveaxis(hs, 0, 2).reshape(B, H, Tp, DV)[:, :, pad:].transpose(0, 2, 1, 3)
    hn = rmsnorm(hs, g_head)
    og = jax.nn.sigmoid(o.astype(f32)).reshape(B, T, H, DV)
    y = (og * hn).reshape(B, T, H * DV).astype(u.dtype)
    return y @ w_out


def dsa_mixer(u, w_in, g_q, g_k, w_out):
    B, T, _ = u.shape
    G, R, hd = A_KV_HEADS, A_HEADS // A_KV_HEADS, A_HEAD_DIM
    f32 = jnp.float32
    p = u @ w_in
    cuts = np.cumsum([A_HEADS * hd, G * hd, G * hd, IDX_HEADS * IDX_DIM, IDX_DIM]).tolist()
    q, k, v, qi, ki, wi = jnp.split(p, cuts, axis=-1)
    pos = jnp.arange(T, dtype=f32)
    q = rope_partial(rmsnorm(q.reshape(B, T, A_HEADS, hd), g_q), pos)
    k = rope_partial(rmsnorm(k.reshape(B, T, G, hd), g_k), pos)
    v = v.reshape(B, T, G, hd)
    qi = rope_partial(qi.reshape(B, T, IDX_HEADS, IDX_DIM), pos)
    ki = rope_partial(ki.reshape(B, T, 1, IDX_DIM), pos)[:, :, 0]
    wi = wi.astype(f32) * (IDX_HEADS ** -0.5 * IDX_DIM ** -0.5)

    topk = min(TOPK_MAX, (T - N_META) // 4)
    QB = SPARSE_Q_BLOCK
    nb = -(-T // QB)
    Tq = nb * QB

    def qblocks(a):
        a = jnp.pad(a, [(0, 0), (0, Tq - T)] + [(0, 0)] * (a.ndim - 2))
        return jnp.moveaxis(a.reshape(B, nb, QB, *a.shape[2:]), 1, 0)

    key_pos = jnp.arange(T)
    q_pos = jnp.arange(Tq).reshape(nb, QB)

    def gather(a, idx):
        return jax.vmap(lambda ab, ib: ab[ib])(a, idx)

    def attend(args):
        qb, qib, wib, tb = args
        sc = jnp.einsum('bqhd,bsd->bqhs', qib, ki, preferred_element_type=f32)
        score = jnp.einsum('bqhs,bqh->bqs', jax.nn.relu(sc), wib)
        admissible = key_pos[None, :] <= tb[:, None]
        score = jnp.where(admissible[None], score, -jnp.inf)
        _, idx = lax.top_k(score, topk)
        valid = idx <= tb[None, :, None]
        k_sel = gather(k, idx)
        v_sel = gather(v, idx)
        qg = qb.reshape(B, QB, G, R, hd)
        logits = jnp.einsum('bqgrd,bqkgd->bqgrk', qg, k_sel, preferred_element_type=f32) * (hd ** -0.5)
        logits = jnp.where(valid[:, :, None, None, :], logits, -jnp.inf)
        prob = jax.nn.softmax(logits, axis=-1).astype(v.dtype)
        return jnp.einsum('bqgrk,bqkgd->bqgrd', prob, v_sel).reshape(B, QB, A_HEADS * hd)

    o = lax.map(attend, (qblocks(q), qblocks(qi), qblocks(wi), q_pos))
    o = jnp.moveaxis(o, 0, 1).reshape(B, Tq, A_HEADS * hd)[:, :T]
    return o @ w_out


def setup_inputs(seed: int = 0) -> dict:
    key = jax.random.key(seed)
    ks = jax.random.split(key, 24)
    f32 = jnp.float32

    def nrm(k, shape, scale):
        return jax.random.normal(k, shape, f32) * scale

    def gain(k, shape):
        return 1.0 + 0.05 * jax.random.normal(k, shape, f32)

    D, F = D_MODEL, D_FF
    return {
        "x": nrm(ks[0], (BATCH, SEQ, D), 1.0),
        "meta_tokens": nrm(ks[1], (N_META, D), 1.0),
        "ffn1_norm": gain(ks[2], (DEPTH, D)),
        "ffn1_w_gate": nrm(ks[3], (DEPTH, D, F), D ** -0.5),
        "ffn1_w_up": nrm(ks[4], (DEPTH, D, F), D ** -0.5),
        "ffn1_w_down": nrm(ks[5], (DEPTH, F, D), F ** -0.5),
        "mix_norm": gain(ks[6], (DEPTH, D)),
        "ffn2_norm": gain(ks[7], (DEPTH, D)),
        "ffn2_w_gate": nrm(ks[8], (DEPTH, D, F), D ** -0.5),
        "ffn2_w_up": nrm(ks[9], (DEPTH, D, F), D ** -0.5),
        "ffn2_w_down": nrm(ks[10], (DEPTH, F, D), F ** -0.5),
        "mlstm_w_in": nrm(ks[11], (N_A, D, M_IN), D ** -0.5),
        "mlstm_b_i": nrm(ks[12], (N_A, M_HEADS), 0.1),
        "mlstm_b_f": 3.0 + nrm(ks[13], (N_A, M_HEADS), 0.5),
        "mlstm_head_norm": gain(ks[14], (N_A, M_HEADS, M_DV)),
        "mlstm_w_out": nrm(ks[15], (N_A, M_HEADS * M_DV, D), (M_HEADS * M_DV) ** -0.5),
        "dsa_w_in": nrm(ks[16], (N_B, D, A_IN), D ** -0.5),
        "dsa_q_norm": gain(ks[17], (N_B, A_HEAD_DIM)),
        "dsa_k_norm": gain(ks[18], (N_B, A_HEAD_DIM)),
        "dsa_w_out": nrm(ks[19], (N_B, A_HEADS * A_HEAD_DIM, D), (A_HEADS * A_HEAD_DIM) ** -0.5),
    }


def reference(x, meta_tokens, ffn1_norm, ffn1_w_gate, ffn1_w_up, ffn1_w_down, mix_norm,
              ffn2_norm, ffn2_w_gate, ffn2_w_up, ffn2_w_down,
              mlstm_w_in, mlstm_b_i, mlstm_b_f, mlstm_head_norm, mlstm_w_out,
              dsa_w_in, dsa_q_norm, dsa_k_norm, dsa_w_out):
    B = x.shape[0]
    meta = jnp.broadcast_to(meta_tokens[None].astype(x.dtype), (B, N_META, D_MODEL))
    h = jnp.concatenate([meta, x], axis=1)
    for layer in range(DEPTH):
        h = h + FFN_HALF * swiglu(rmsnorm(h, ffn1_norm[layer]), ffn1_w_gate[layer], ffn1_w_up[layer], ffn1_w_down[layer])
        u = rmsnorm(h, mix_norm[layer])
        j = layer // N_MIXERS
        if layer % N_MIXERS == 0:
            mix = mlstm_mixer(u, mlstm_w_in[j], mlstm_b_i[j], mlstm_b_f[j], mlstm_head_norm[j], mlstm_w_out[j])
        else:
            mix = dsa_mixer(u, dsa_w_in[j], dsa_q_norm[j], dsa_k_norm[j], dsa_w_out[j])
        h = h + mix
        h = h + FFN_HALF * swiglu(rmsnorm(h, ffn2_norm[layer]), ffn2_w_gate[layer], ffn2_w_up[layer], ffn2_w_down[layer])
    return h[:, N_META:]
```

```cpp
#include <hip/hip_runtime.h>
#include <hip/hip_cooperative_groups.h>
#include <cstdio>
#include <cstdint>
namespace cg = cooperative_groups;

constexpr int NB = 16, SEQ = 2048, NMETA = 16, T = 2064, D = 2048, FF = 5632, M = NB * T;
constexpr int MINP = 6400, AINP = 4352, TP = 2112;
constexpr float EPS = 1e-6f;
constexpr int LDS_BYTES = 147456;
constexpr int NTHREADS = 512;

constexpr size_t SZ_GU = (size_t)2 * FF * D * 2, SZ_DN = (size_t)D * FF * 2;
constexpr size_t WS_GU = 0, WS_DN = 4 * SZ_GU, WS_MIN = WS_DN + 4 * SZ_DN, WS_MOUT = WS_MIN + (size_t)MINP * D * 2,
                 WS_AIN = WS_MOUT + (size_t)D * D * 2, WS_AOUT = WS_AIN + (size_t)AINP * D * 2, WS_HB = WS_AOUT + (size_t)D * D * 2,
                 WS_P = WS_HB + (size_t)M * D * 2, WS_HMETA = WS_P + (size_t)M * MINP * 2, WS_SSQ = WS_HMETA + (size_t)NB * NMETA * D * 4,
                 WS_MASK = WS_SSQ + 6 * (size_t)M * 128, WS_VT = WS_MASK + (size_t)M * 66 * 4, WS_PART = WS_VT + (size_t)NB * 4 * 128 * TP * 2, WS_BAR = WS_PART + (size_t)8 * 22 * 256 * 256 * 4, WS_KIC = WS_BAR + 16384, WS_RSTD = WS_KIC + (size_t)M * 64 * 2, WS_END = WS_RSTD + 6 * (size_t)M * 4;

namespace pg8 {
#define PG8_LAS __attribute__((address_space(3)))
typedef unsigned short bf16_t;
typedef short bf16x8 __attribute__((ext_vector_type(8)));
typedef float f32x4 __attribute__((ext_vector_type(4)));
typedef unsigned u32x4 __attribute__((ext_vector_type(4)));
typedef unsigned u32x2 __attribute__((ext_vector_type(2)));
constexpr int BM = 256, BK = 64, HALF = 128, HTB = HALF * BK * 2  , STAGE_BYTES = 8 * HTB, NXCD = 8, WGM = 4;

__host__ __device__ __forceinline__ int lds_byte(int r, int c) { const int st = (r >> 4) * 2 + (c >> 5), rr = r & 15, cc = c & 31, ob = rr * 64 + cc * 2; return st * 1024 + (ob ^ (((ob >> 9) & 1) << 5)); }
__host__ __device__ __forceinline__ void stage_rc(int b, int& R, int& C) { const int st = b / 1024, sb = b % 1024, swz = sb ^ (((sb >> 9) & 1) << 5); R = (st >> 1) * 16 + swz / 64; C = (st & 1) * 32 + (swz % 64) / 2; }
__host__ __device__ __forceinline__ int perm32(int rho) { const int n = rho >> 4, i = rho & 15; return 8 * (i >> 2) + 4 * n + (i & 3); }

struct Unit { int pm, pn, kt0, nkt, slice; };
struct Gemm { const bf16_t* A; const bf16_t* Bt; int M, N, K, lda; };

struct StaticOrder {
    int nM, nN, nwg, G, c, ntK;
    __host__ __device__ void init(int M, int N, int K, int G_, int c_) { nM = M / BM; nN = N / BM; nwg = nM * nN; G = G_; c = c_; ntK = K / BK; }
    __host__ __device__ __forceinline__ Unit next(int i) const {
        Unit u; u.pm = -1; u.pn = 0; u.kt0 = 0; u.nkt = ntK; u.slice = -1;
        const long L = (long)i * G + c; if (L >= nwg) return u;
        int wgid = (int)L; { const int q = nwg / NXCD, r = nwg % NXCD, xcd = wgid % NXCD, off = wgid / NXCD; wgid = (xcd < r ? xcd * (q + 1) : r * (q + 1) + (xcd - r) * q) + off; }
        const int nig = WGM * nN, gid = wgid / nig, fm = gid * WGM, gsz = (nM - fm) < WGM ? (nM - fm) : WGM;
        u.pm = fm + ((wgid % nig) % gsz); u.pn = (wgid % nig) / gsz; return u;
    }
    __device__ __forceinline__ void a_ready(const Unit&) const {}
    __device__ __forceinline__ void done(const Unit&) const {}
};
struct TailOrder {
    StaticOrder S; int NS, kts, pmLast;
    __host__ __device__ void init(int M, int N, int K, int NS_, int G_, int c_) { S.init(M - BM, N, K, G_, c_); NS = NS_; kts = (K / BK) / NS_; pmLast = M / BM - 1; }
    __host__ __device__ __forceinline__ Unit next(int i) const {
        const long L = (long)i * S.G + S.c;
        if (L < S.nwg) return S.next(i);
        Unit u; u.pm = -1; u.pn = 0; u.kt0 = 0; u.nkt = kts; u.slice = -1;
        const int item = (int)(L - S.nwg); if (item >= S.nN * NS) return u;
        u.pm = pmLast; u.pn = item / NS; u.slice = item - u.pn * NS; u.kt0 = u.slice * kts; return u;
    }
    __device__ __forceinline__ void a_ready(const Unit&) const {}
    __device__ __forceinline__ void done(const Unit&) const {}
};
typedef __bf16 bf16n2 __attribute__((ext_vector_type(2)));
typedef float f32x2n __attribute__((ext_vector_type(2)));
__device__ __forceinline__ unsigned cvt_pk_bf16(float lo, float hi) { const f32x2n v = {lo, hi}; return __builtin_bit_cast(unsigned, __builtin_convertvector(v, bf16n2)); }

__device__ __forceinline__ float row_rstd(const float* rstd, int row) { return rstd[row]; }
struct EpiSwiglu {
    static constexpr bool PERM = true, AFTER_DRAIN = false;
    bf16_t* O; const float* ssq;
    __device__ __forceinline__ void operator()(const f32x4 (&acc)[2][2][4][2], const Unit& u, int wr, int wc, int fr, int fq) const {
        const int row0 = u.pm * BM + wr * 64 + fr, col = u.pn * HALF + wc * 32 + 8 * fq;
#pragma unroll
        for (int ai = 0; ai < 2; ++ai)
#pragma unroll
            for (int m = 0; m < 4; ++m) {
                const int row = row0 + ai * HALF + m * 16; const float rs = row_rstd(ssq, row);
                float o[8];
#pragma unroll
                for (int n = 0; n < 2; ++n)
#pragma unroll
                    for (int j = 0; j < 4; ++j) { const float g = acc[ai][0][m][n][j] * rs, uu = acc[ai][1][m][n][j] * rs;
                        o[n * 4 + j] = g * __builtin_amdgcn_rcpf(1.0f + __builtin_amdgcn_exp2f(-1.4426950408889634f * g)) * uu; }
                u32x4 w; w.x = cvt_pk_bf16(o[0], o[1]); w.y = cvt_pk_bf16(o[2], o[3]); w.z = cvt_pk_bf16(o[4], o[5]); w.w = cvt_pk_bf16(o[6], o[7]);
                *(u32x4*)(O + (size_t)row * FF + col) = w;
            }
    }
};
struct EpiRowScale {
    static constexpr bool PERM = true, AFTER_DRAIN = false;
    bf16_t* O; int ldc; const float* ssq;
    __device__ __forceinline__ void operator()(const f32x4 (&acc)[2][2][4][2], const Unit& u, int wr, int wc, int fr, int fq) const {
        const int row0 = u.pm * BM + wr * 64 + fr, col0 = u.pn * BM + wc * 32 + 8 * fq;
#pragma unroll
        for (int ai = 0; ai < 2; ++ai)
#pragma unroll
            for (int m = 0; m < 4; ++m) {
                const int row = row0 + ai * HALF + m * 16; const float rs = row_rstd(ssq, row);
#pragma unroll
                for (int bj = 0; bj < 2; ++bj) { const f32x4 v0 = acc[ai][bj][m][0] * rs, v1 = acc[ai][bj][m][1] * rs;
                    u32x4 w; w.x = cvt_pk_bf16(v0[0], v0[1]); w.y = cvt_pk_bf16(v0[2], v0[3]); w.z = cvt_pk_bf16(v1[0], v1[1]); w.w = cvt_pk_bf16(v1[2], v1[3]);
                    *(u32x4*)(O + (size_t)row * ldc + col0 + bj * HALF) = w; }
            }
    }
};
struct EpiResid {
    static constexpr bool PERM = true, AFTER_DRAIN = false;
    bf16_t* hb; float* ssq_next; float* fout; float scale; float* part; int NS;
    __device__ __forceinline__ void operator()(const f32x4 (&acc)[2][2][4][2], const Unit& u, int wr, int wc, int fr, int fq) const {
        if (u.slice >= 0) {
            float* pp = part + ((size_t)(u.pn * NS + u.slice) * BM + wr * 64 + fr) * BM + wc * 32 + 8 * fq;
#pragma unroll
            for (int ai = 0; ai < 2; ++ai)
#pragma unroll
                for (int m = 0; m < 4; ++m)
#pragma unroll
                    for (int bj = 0; bj < 2; ++bj) { float* q = pp + (size_t)(ai * HALF + m * 16) * BM + bj * HALF; *(f32x4*)q = acc[ai][bj][m][0]; *(f32x4*)(q + 4) = acc[ai][bj][m][1]; }
            return;
        }
        const int row0 = u.pm * BM + wr * 64 + fr, col0 = u.pn * BM + wc * 32 + 8 * fq;
#pragma unroll
        for (int ai = 0; ai < 2; ++ai) {
            u32x4 hv[4][2];
#pragma unroll
            for (int m = 0; m < 4; ++m)
#pragma unroll
                for (int bj = 0; bj < 2; ++bj) hv[m][bj] = *(const u32x4*)(hb + (size_t)(row0 + ai * HALF + m * 16) * D + col0 + bj * HALF);
#pragma unroll
            for (int m = 0; m < 4; ++m) {
                const int row = row0 + ai * HALF + m * 16; float ss = 0.f;
                const int b = row / T, t = row - b * T; float* op = fout + ((size_t)b * SEQ + (t - NMETA)) * D + col0;
#pragma unroll
                for (int bj = 0; bj < 2; ++bj) { const u32x4 v = hv[m][bj];
                    f32x4 h0 = {__builtin_bit_cast(float, v.x << 16), __builtin_bit_cast(float, v.x & 0xffff0000u), __builtin_bit_cast(float, v.y << 16), __builtin_bit_cast(float, v.y & 0xffff0000u)};
                    f32x4 h1 = {__builtin_bit_cast(float, v.z << 16), __builtin_bit_cast(float, v.z & 0xffff0000u), __builtin_bit_cast(float, v.w << 16), __builtin_bit_cast(float, v.w & 0xffff0000u)};
                    h0 += acc[ai][bj][m][0] * scale; h1 += acc[ai][bj][m][1] * scale;
                    if (fout) { if (t >= NMETA) { *(f32x4*)(op + bj * HALF) = h0; *(f32x4*)(op + bj * HALF + 4) = h1; } }
                    else { u32x4 w; w.x = cvt_pk_bf16(h0[0], h0[1]); w.y = cvt_pk_bf16(h0[2], h0[3]); w.z = cvt_pk_bf16(h1[0], h1[1]); w.w = cvt_pk_bf16(h1[2], h1[3]);
                        *(u32x4*)(hb + (size_t)row * D + col0 + bj * HALF) = w;
                        ss += (h0[0] * h0[0] + h0[1] * h0[1]) + (h0[2] * h0[2] + h0[3] * h0[3]) + (h1[0] * h1[0] + h1[1] * h1[1]) + (h1[2] * h1[2] + h1[3] * h1[3]); }
                }
                if (!fout) { ss += __shfl_xor(ss, 16); ss += __shfl_xor(ss, 32); if (fq == 0) ssq_next[(size_t)row * 32 + u.pn * 4 + wc] = ss; }
            }
        }
    }
};
template <class Epi, class Sched, bool ALIGN_EPI = false, bool SP2 = false>
__device__ __forceinline__ void gemm_phase(PG8_LAS unsigned char* lds, const Gemm g, const Sched& S, const Epi& E) {
    const int tid = threadIdx.x, wid = __builtin_amdgcn_readfirstlane(tid >> 6), lane = tid & 63, wr = wid >> 2, wc = wid & 3, fr = lane & 15, fq = lane >> 4;
    const int K = g.K;
    unsigned voffA[2], voffB[2];
#pragma unroll
    for (int i = 0; i < 2; ++i) { int R, C; stage_rc(tid * 16 + i * 8192, R, C); const int Rb = Epi::PERM ? ((R & ~31) + perm32(R & 31)) : R;
        voffA[i] = (unsigned)(R * g.lda + C) * 2u; voffB[i] = (unsigned)(Rb * K + C) * 2u; }
    const size_t kstep = (size_t)(BK * 2);
    const size_t hstepA = (size_t)HALF * g.lda * 2, hstepB = (size_t)HALF * K * 2;
    const size_t tstepA = 2 * hstepA, tstepB = 2 * hstepB;
    const unsigned ldsw = (unsigned)wid * 1024u;
    const int aoff = lds_byte(wr * 64 + fr, fq * 8), boff = lds_byte(wc * 32 + fr, fq * 8);
#define PG8_SA(b, h) (((b) * 2 + (h)) * HTB)
#define PG8_SB(b, h) ((4 + (b) * 2 + (h)) * HTB)
#define PG8_STAGE(bufoff, gbase, voff) do { _Pragma("unroll") for (int _i = 0; _i < 2; ++_i) \
        __builtin_amdgcn_global_load_lds((const unsigned*)((const char*)(gbase) + (voff)[_i]), (PG8_LAS unsigned*)(lds + (bufoff) + ldsw + _i * 8192), 16, 0, 0); } while (0)
#define PG8_LDA(dst, b, h) do { _Pragma("unroll") for (int m = 0; m < 4; ++m) _Pragma("unroll") for (int k = 0; k < 2; ++k) dst[m][k] = *(const PG8_LAS bf16x8*)(lds + PG8_SA(b, h) + aoff + m * 2048 + k * 1024); } while (0)
#define PG8_LDB(dst, b, h) do { _Pragma("unroll") for (int n = 0; n < 2; ++n) _Pragma("unroll") for (int k = 0; k < 2; ++k) dst[n][k] = *(const PG8_LAS bf16x8*)(lds + PG8_SB(b, h) + boff + n * 2048 + k * 1024); } while (0)
#define PG8_MMA(ai, bj, At, Bt) do { __builtin_amdgcn_s_setprio(1); _Pragma("unroll") for (int m = 0; m < 4; ++m) _Pragma("unroll") for (int n = 0; n < 2; ++n) _Pragma("unroll") for (int k = 0; k < 2; ++k) \
        acc[ai][bj][m][n] = __builtin_amdgcn_mfma_f32_16x16x32_bf16(Bt[n][k], At[m][k], acc[ai][bj][m][n], 0, 0, 0); __builtin_amdgcn_s_setprio(0); } while (0)
#define PG8_WAIT_V(n) asm volatile("s_waitcnt vmcnt(" #n ")" ::: "memory")
#define PG8_WAIT_L(n) asm volatile("s_waitcnt lgkmcnt(" #n ")" ::: "memory")
#define PG8_BAR __builtin_amdgcn_s_barrier()
#define PG8_SCHED __builtin_amdgcn_sched_barrier(0)
    Unit cur, nxt; int ui = 0;
    cur = S.next(0); if (cur.pm < 0) return;
    f32x4 acc[2][2][4][2];
#pragma unroll
    for (int a = 0; a < 2; ++a)
#pragma unroll
        for (int b = 0; b < 2; ++b)
#pragma unroll
            for (int m = 0; m < 4; ++m)
#pragma unroll
                for (int n = 0; n < 2; ++n) acc[a][b][m][n] = (f32x4){0.f, 0.f, 0.f, 0.f};
    bf16x8 At[4][2], B0[2][2], B1[2][2];
    const char* cA = (const char*)g.A + (size_t)cur.pm * tstepA + (size_t)cur.kt0 * (BK * 2); const char* cB = (const char*)g.Bt + (size_t)cur.pn * tstepB + (size_t)cur.kt0 * (BK * 2);
    S.a_ready(cur);
    if constexpr (SP2) {
        PG8_STAGE(PG8_SB(0, 0), cB, voffB); PG8_STAGE(PG8_SB(0, 1), cB + hstepB, voffB); PG8_STAGE(PG8_SA(0, 0), cA, voffA); PG8_STAGE(PG8_SA(0, 1), cA + hstepA, voffA);
        if (wr == 1) PG8_BAR;
        PG8_WAIT_V(2); PG8_BAR;
        PG8_STAGE(PG8_SB(1, 0), cB + kstep, voffB); PG8_STAGE(PG8_SA(1, 0), cA + kstep, voffA); PG8_STAGE(PG8_SB(1, 1), cB + hstepB + kstep, voffB);
        PG8_WAIT_V(6); PG8_BAR;
    } else {
        PG8_STAGE(PG8_SB(0, 0), cB, voffB); PG8_STAGE(PG8_SA(0, 0), cA, voffA); PG8_STAGE(PG8_SB(0, 1), cB + hstepB, voffB); PG8_STAGE(PG8_SA(0, 1), cA + hstepA, voffA);
        if (wr == 1) PG8_BAR;
        PG8_WAIT_V(4); PG8_BAR;
        PG8_STAGE(PG8_SB(1, 0), cB + kstep, voffB); PG8_STAGE(PG8_SA(1, 0), cA + kstep, voffA); PG8_STAGE(PG8_SB(1, 1), cB + hstepB + kstep, voffB);
        PG8_WAIT_V(6); PG8_BAR;
    }
    for (;;) {
        nxt = S.next(ui + 1); const bool has_next = nxt.pm >= 0;
        const char* nA = has_next ? (const char*)g.A + (size_t)nxt.pm * tstepA + (size_t)nxt.kt0 * (BK * 2) : cA; const char* nB = has_next ? (const char*)g.Bt + (size_t)nxt.pn * tstepB + (size_t)nxt.kt0 * (BK * 2) : cB;
        const int nt = cur.nkt;
        for (int t = 0; t < nt; t += 2) {
            const bool last = (t == nt - 2);
            const char* a1 = cA + (size_t)(t + 1) * kstep;
            const char* a2 = last ? nA : cA + (size_t)(t + 2) * kstep; const char* b2 = last ? nB : cB + (size_t)(t + 2) * kstep;
            const char* a3 = a2 + kstep; const char* b3 = b2 + kstep;
            if (last && has_next) S.a_ready(nxt);
            if constexpr (SP2) {
            PG8_LDB(B0, 0, 0); PG8_LDB(B1, 0, 1); PG8_SCHED; PG8_LDA(At, 0, 0); PG8_STAGE(PG8_SA(1, 1), a1 + hstepA, voffA);
            PG8_WAIT_V(8); PG8_WAIT_L(0); PG8_BAR; PG8_MMA(0, 0, At, B0); PG8_MMA(0, 1, At, B1); PG8_BAR; PG8_SCHED;
            PG8_LDA(At, 0, 1); PG8_STAGE(PG8_SB(0, 0), b2, voffB); PG8_STAGE(PG8_SB(0, 1), b2 + hstepB, voffB); PG8_STAGE(PG8_SA(0, 0), a2, voffA);
            PG8_WAIT_V(8); PG8_WAIT_L(0); PG8_BAR; PG8_MMA(1, 0, At, B0); PG8_MMA(1, 1, At, B1); PG8_BAR; PG8_SCHED;
            PG8_LDB(B0, 1, 0); PG8_LDB(B1, 1, 1); PG8_SCHED; PG8_LDA(At, 1, 0); PG8_STAGE(PG8_SA(0, 1), a2 + hstepA, voffA);
            PG8_WAIT_V(8); PG8_WAIT_L(0); PG8_BAR; PG8_MMA(0, 0, At, B0); PG8_MMA(0, 1, At, B1); PG8_BAR; PG8_SCHED;
            PG8_LDA(At, 1, 1); PG8_STAGE(PG8_SB(1, 0), b3, voffB); PG8_STAGE(PG8_SB(1, 1), b3 + hstepB, voffB); PG8_STAGE(PG8_SA(1, 0), a3, voffA);
            PG8_WAIT_V(8); PG8_WAIT_L(0); PG8_BAR; PG8_MMA(1, 0, At, B0); PG8_MMA(1, 1, At, B1); PG8_BAR; PG8_SCHED;
            } else {
            PG8_LDB(B0, 0, 0); PG8_SCHED; PG8_LDA(At, 0, 0); PG8_STAGE(PG8_SA(1, 1), a1 + hstepA, voffA);
            PG8_WAIT_L(8); PG8_BAR; PG8_WAIT_L(0); PG8_MMA(0, 0, At, B0); PG8_BAR; PG8_SCHED;
            PG8_LDB(B1, 0, 1); PG8_STAGE(PG8_SB(0, 0), b2, voffB);
            PG8_BAR; PG8_WAIT_L(0); PG8_MMA(0, 1, At, B1); PG8_BAR;
            PG8_LDA(At, 0, 1); PG8_STAGE(PG8_SA(0, 0), a2, voffA);
            PG8_BAR; PG8_WAIT_L(0); PG8_MMA(1, 0, At, B0); PG8_BAR; PG8_SCHED;
            PG8_STAGE(PG8_SB(0, 1), b2 + hstepB, voffB);
            PG8_WAIT_V(6); PG8_BAR; PG8_MMA(1, 1, At, B1); PG8_BAR;
            PG8_LDB(B0, 1, 0); PG8_SCHED; PG8_LDA(At, 1, 0); PG8_STAGE(PG8_SA(0, 1), a2 + hstepA, voffA);
            PG8_WAIT_L(8); PG8_BAR; PG8_WAIT_L(0); PG8_MMA(0, 0, At, B0); PG8_BAR; PG8_SCHED;
            PG8_LDB(B1, 1, 1); PG8_STAGE(PG8_SB(1, 0), b3, voffB);
            PG8_BAR; PG8_WAIT_L(0); PG8_MMA(0, 1, At, B1); PG8_BAR;
            PG8_LDA(At, 1, 1); PG8_STAGE(PG8_SA(1, 0), a3, voffA);
            PG8_BAR; PG8_WAIT_L(0); PG8_MMA(1, 0, At, B0); PG8_BAR; PG8_SCHED;
            PG8_STAGE(PG8_SB(1, 1), b3 + hstepB, voffB);
            PG8_WAIT_V(6); PG8_BAR; PG8_MMA(1, 1, At, B1); PG8_BAR;
            }
        }
        if constexpr (ALIGN_EPI) { if (wr == 0) PG8_BAR; }
        if constexpr (!Epi::AFTER_DRAIN) { E(acc, cur, wr, wc, fr, fq); S.done(cur); }
        if (!has_next) break;
#pragma unroll
        for (int a = 0; a < 2; ++a)
#pragma unroll
            for (int b = 0; b < 2; ++b)
#pragma unroll
                for (int m = 0; m < 4; ++m)
#pragma unroll
                    for (int n = 0; n < 2; ++n) acc[a][b][m][n] = (f32x4){0.f, 0.f, 0.f, 0.f};
        cur = nxt; cA = nA; cB = nB; ++ui;
        if constexpr (ALIGN_EPI) { if (wr == 1) PG8_BAR; }
    }
    PG8_WAIT_V(0);
    if constexpr (!ALIGN_EPI) { if (wr == 0) PG8_BAR; }
    PG8_BAR;
    if constexpr (Epi::AFTER_DRAIN) { E.fused(acc, cur, wr, wc, fr, fq, lds, wid, lane); S.done(cur); }
#undef PG8_SA
#undef PG8_SB
#undef PG8_STAGE
#undef PG8_LDA
#undef PG8_LDB
#undef PG8_MMA
#undef PG8_WAIT_V
#undef PG8_WAIT_L
#undef PG8_BAR
#undef PG8_SCHED
}
}
using pg8::bf16_t; using pg8::bf16x8; using pg8::f32x4; using pg8::u32x4; using pg8::u32x2; using pg8::cvt_pk_bf16;
#define LAS __attribute__((address_space(3)))
typedef short bf16x4 __attribute__((ext_vector_type(4)));
#define LDS_WAIT() asm volatile("s_waitcnt lgkmcnt(0)" ::: "memory")
__device__ __forceinline__ float bf2f(unsigned h) { return __builtin_bit_cast(float, h << 16); }
__device__ __forceinline__ float bflo(unsigned w) { return __builtin_bit_cast(float, w << 16); }
__device__ __forceinline__ float bfhi(unsigned w) { return __builtin_bit_cast(float, w & 0xffff0000u); }
__device__ __forceinline__ unsigned short f2bf1(float f) { return (unsigned short)(cvt_pk_bf16(f, 0.f) & 0xffffu); }
__device__ __forceinline__ float wave_sum(float v) {
#pragma unroll
    for (int o = 1; o < 64; o <<= 1) v += __shfl_xor(v, o);
    return v;
}
__device__ __forceinline__ f32x4 mfma16(bf16x8 a, bf16x8 b, f32x4 c) { return __builtin_amdgcn_mfma_f32_16x16x32_bf16(a, b, c, 0, 0, 0); }
__device__ __forceinline__ bf16x8 cat8(u32x2 lo, u32x2 hi) { u32x4 w; w.x = lo.x; w.y = lo.y; w.z = hi.x; w.w = hi.y; return __builtin_bit_cast(bf16x8, w); }

#define XB_TMO      128
#define XB_XCNT(j)  (256  + 64 * (j))
#define XB_XSUB(j)  (1280 + 64 * (j))
#define XB_XGEN(j)  (2304 + 64 * (j))
#define XB_TOP      3328
#define XB_TOPGEN   3392
#define XCD_BAR_WORDS 3456
#define XB_SPIN_CAP (1u << 18)

__device__ __forceinline__ unsigned xb_ld(unsigned* p)              { return __hip_atomic_load(p, __ATOMIC_RELAXED, __HIP_MEMORY_SCOPE_AGENT); }
__device__ __forceinline__ unsigned xb_add(unsigned* p, unsigned v) { return __hip_atomic_fetch_add(p, v, __ATOMIC_RELAXED, __HIP_MEMORY_SCOPE_AGENT); }
__device__ __forceinline__ unsigned xb_xcc_id() { return (unsigned)__builtin_amdgcn_s_getreg((3 << 11) | 20) & 0xFu; }
#define XB_SPIN(cond, bar) do { unsigned _sp = 0; while (cond) { __builtin_amdgcn_s_sleep(1); \
    if ((++_sp & 255u) == 0u) { if (xb_ld(&(bar)[XB_TMO])) break; if (_sp > XB_SPIN_CAP) { atomicAdd(&(bar)[XB_TMO], 1u); break; } } } } while (0)

struct XcdBarrier {
    unsigned* bar; unsigned x;
    volatile LAS unsigned* st;
};

__device__ __forceinline__ XcdBarrier xcd_barrier_post(unsigned* bar, volatile LAS unsigned* st) {
    XcdBarrier b; b.bar = bar; b.x = xb_xcc_id(); b.st = st;
    if (threadIdx.x == 0) (void)xb_add(&bar[XB_XCNT(b.x)], 1u);
    return b;
}
__device__ __forceinline__ void xcd_barrier_complete(unsigned* bar, unsigned x, unsigned& nloc, unsigned& nx) {
    const unsigned G = gridDim.x * gridDim.y * gridDim.z;
    unsigned sum, cnt, mine, sp = 0u;
    for (;;) {
        sum = 0u; cnt = 0u; mine = 0u;
#pragma unroll
        for (unsigned j = 0; j < 16; ++j) { const unsigned c = xb_ld(&bar[XB_XCNT(j)]); sum += c; cnt += (c > 0u) ? 1u : 0u; mine = (j == x) ? c : mine; }
        if (sum == G) break;
        __builtin_amdgcn_s_sleep(1);
        if ((++sp & 255u) == 0u) { if (xb_ld(&bar[XB_TMO])) break; if (sp > XB_SPIN_CAP) { atomicAdd(&bar[XB_TMO], 1u); break; } }
    }
    nloc = mine > 0u ? mine : 1u; nx = cnt > 0u ? cnt : 1u;
}

__device__ __forceinline__ void xcd_barrier(const XcdBarrier& b) {
    asm volatile("s_waitcnt vmcnt(0)" ::: "memory");
    __syncthreads();
    if (threadIdx.x == 0) {
        unsigned* bar = b.bar;
        __builtin_amdgcn_s_waitcnt(0);
        unsigned nloc = b.st[0], nx = b.st[1];
        if (nloc == 0u) { xcd_barrier_complete(bar, b.x, nloc, nx); b.st[0] = nloc; b.st[1] = nx; }
        const unsigned old = xb_add(&bar[XB_XSUB(b.x)], 1u);
        const unsigned gen = old / nloc;
        if (old + 1u == (gen + 1u) * nloc) {
            __builtin_amdgcn_fence(__ATOMIC_RELEASE, "agent");
            asm volatile("s_waitcnt vmcnt(0)" ::: "memory");
            const unsigned og = xb_add(&bar[XB_TOP], 1u);
            const unsigned tg = og / nx;
            if (og + 1u == (tg + 1u) * nx) xb_add(&bar[XB_TOPGEN], 1u);
            else XB_SPIN(xb_ld(&bar[XB_TOPGEN]) == tg, bar);
            __builtin_amdgcn_fence(__ATOMIC_ACQUIRE, "agent");
            xb_add(&bar[XB_XGEN(b.x)], 1u);
            asm volatile("s_waitcnt vmcnt(0)" ::: "memory");
        } else {
            XB_SPIN(xb_ld(&bar[XB_XGEN(b.x)]) == gen, bar);
            __builtin_amdgcn_fence(__ATOMIC_ACQUIRE, "agent");
            asm volatile("s_waitcnt vmcnt(0)" ::: "memory");
        }
    }
    __syncthreads();
}

struct Args { const float* in[20]; float* out; unsigned char* ws; int ph_lo, ph_hi; };

__device__ __forceinline__ void transpose_item(const float* W, int K, int N, bf16_t* WT, int dst_row0, const float* gain, int qcols, LAS float* scr, int kb, int nb, int lane) {
    const int k0 = 64 * kb, n0 = 64 * nb, n4 = lane & 15, kr = lane >> 4, n = n0 + 4 * n4; const bool nin = n < N; const float cs = (n < qcols) ? 0.0625f : 1.0f;
    f32x4 v[16];
#pragma unroll
    for (int i = 0; i < 16; ++i) { v[i] = (f32x4){0.f, 0.f, 0.f, 0.f}; if (nin) v[i] = *(const f32x4*)(W + (size_t)(k0 + 4 * i + kr) * N + n); }
#pragma unroll
    for (int i = 0; i < 16; ++i) { const int kk = 4 * i + kr; const float gk = (gain ? gain[k0 + kk] : 1.0f) * cs; LAS float* d = scr + kk * 65 + 4 * n4;
        d[0] = v[i][0] * gk; d[1] = v[i][1] * gk; d[2] = v[i][2] * gk; d[3] = v[i][3] * gk; }
    LDS_WAIT();
    const int c = lane & 7;
#pragma unroll
    for (int j = 0; j < 8; ++j) { const int nn = (lane >> 3) + 8 * j; const LAS float* s = scr + (8 * c) * 65 + nn;
        u32x4 o; o.x = cvt_pk_bf16(s[0 * 65], s[1 * 65]); o.y = cvt_pk_bf16(s[2 * 65], s[3 * 65]); o.z = cvt_pk_bf16(s[4 * 65], s[5 * 65]); o.w = cvt_pk_bf16(s[6 * 65], s[7 * 65]);
        *(u32x4*)(WT + (size_t)(dst_row0 + nn) * K + k0 + 8 * c) = o; }
    LDS_WAIT();
}
__device__ __forceinline__ void prologue_phase(LAS unsigned char* lds, const Args& a) {
    const int tid = threadIdx.x, lane = tid & 63, wid = tid >> 6;
    const int gw = blockIdx.x * 8 + wid, NGW = gridDim.x * 8;
    LAS float* scr = (LAS float*)(lds + wid * 16640);
    unsigned char* ws = a.ws;
    constexpr int I_G = (D / 64) * (FF / 64), I_D = (FF / 64) * (D / 64), I_MI = (D / 64) * (MINP / 64), I_O = (D / 64) * (D / 64), I_AI = (D / 64) * (AINP / 64);
    constexpr int NITEMS = 12 * I_G + I_MI + 2 * I_O + I_AI;
    static_assert(I_G == I_D, "items");
    for (int it = gw; it < NITEMS; it += NGW) {
        int r = it;
        if (r < 12 * I_G) {
            const int f = r / (3 * I_G); r -= f * 3 * I_G; const int which = r / I_G; r -= which * I_G;
            const int layer = f >> 1, second = f & 1;
            if (which < 2) {
                const float* W = a.in[(second ? 8 : 3) + which] + (size_t)layer * D * FF; const float* gain = a.in[second ? 7 : 2] + layer * D;
                const int nblk = FF / 64, kb = r / nblk, nb = r % nblk, n0 = 64 * nb;
                const int dst_row0 = (n0 >> 7) * 256 + which * 128 + (n0 & 127);
                transpose_item(W, D, FF, (bf16_t*)(ws + WS_GU + f * SZ_GU), dst_row0, gain, 0, scr, kb, nb, lane);
            } else {
                const float* W = a.in[second ? 10 : 5] + (size_t)layer * FF * D;
                const int nblk = D / 64, kb = r / nblk, nb = r % nblk;
                transpose_item(W, FF, D, (bf16_t*)(ws + WS_DN + f * SZ_DN), 64 * nb, nullptr, 0, scr, kb, nb, lane);
            }
            continue;
        }
        r -= 12 * I_G;
        if (r < I_MI) { const int nblk = MINP / 64, kb = r / nblk, nb = r % nblk; transpose_item(a.in[11], D, 6152, (bf16_t*)(ws + WS_MIN), 64 * nb, a.in[6], 1024, scr, kb, nb, lane); continue; }
        r -= I_MI;
        if (r < I_O) { const int nblk = D / 64, kb = r / nblk, nb = r % nblk; transpose_item(a.in[15], D, D, (bf16_t*)(ws + WS_MOUT), 64 * nb, nullptr, 0, scr, kb, nb, lane); continue; }
        r -= I_O;
        if (r < I_AI) { const int nblk = AINP / 64, kb = r / nblk, nb = r % nblk; transpose_item(a.in[16], D, 4176, (bf16_t*)(ws + WS_AIN), 64 * nb, a.in[6] + D, 0, scr, kb, nb, lane); continue; }
        r -= I_AI;
        { const int nblk = D / 64, kb = r / nblk, nb = r % nblk; transpose_item(a.in[19], D, D, (bf16_t*)(ws + WS_AOUT), 64 * nb, nullptr, 0, scr, kb, nb, lane); }
    }
    bf16_t* hb = (bf16_t*)(ws + WS_HB); float* rstd0 = (float*)(ws + WS_RSTD);
    for (int r = gw; r < M; r += NGW) {
        const int b = r / T, t = r - b * T;
        const float* src = t < NMETA ? a.in[1] + (size_t)t * D : a.in[0] + ((size_t)b * SEQ + (t - NMETA)) * D;
        float ss = 0.f;
#pragma unroll
        for (int j = 0; j < 8; ++j) { const f32x4 v = ((const f32x4*)src)[lane + 64 * j];
            u32x2 w; w.x = cvt_pk_bf16(v[0], v[1]); w.y = cvt_pk_bf16(v[2], v[3]); *(u32x2*)(hb + (size_t)r * D + 4 * (lane + 64 * j)) = w;
            ss += (v[0] * v[0] + v[1] * v[1]) + (v[2] * v[2] + v[3] * v[3]); }
        ss = wave_sum(ss); if (lane == 0) rstd0[r] = __builtin_amdgcn_rsqf(ss * (1.0f / D) + EPS);
    }
}

constexpr int ML_Q = 0, ML_K = 33792, ML_KT = 67584, ML_VT = 104448, ML_SP = 122880, ML_FL = 132096;
__device__ __forceinline__ float logsigmoid(float x) { return fminf(x, 0.f) - log1pf(__expf(-fabsf(x))); }
__device__ __forceinline__ void mlstm_scan_phase(LAS unsigned char* lds, const bf16_t* P, bf16_t* Hout, int ldh, const float* b_i, const float* b_f) {
    const int tid = threadIdx.x, wid = __builtin_amdgcn_readfirstlane(tid >> 6), lane = tid & 63, fr = lane & 15, fq = lane >> 4;
    LAS float* fa = (LAS float*)(lds + ML_FL); LAS float* fMx = fa + 64; LAS float* fwk = fa + 128; LAS float* fwi = fa + 192; LAS float* fef = fa + 256;
    LAS float* frs = fa + 320; LAS float* fqn = fa + 384; LAS float* fn = fa + 448; LAS float* fmisc = fa + 704; LAS float* fsc = fa + 720; LAS float* frs4 = fa + 784;
    for (int unit = blockIdx.x; unit < 256; unit += gridDim.x) {
        const int bh = unit >> 2, sl = unit & 3, b = bh >> 2, h = bh & 3;
        f32x4 C[16];
#pragma unroll
        for (int i = 0; i < 16; ++i) C[i] = (f32x4){0.f, 0.f, 0.f, 0.f};
        if (tid < 256) fn[tid] = 0.f;
        float m_run = 0.f;
        const float bi = b_i[h], bfv = b_f[h];
        const size_t rowb = (size_t)b * T;
        unsigned short g_i = 0, g_f = 0;
        if (wid == 0) { const int tg = lane - 48; const bf16_t* pr = P + (rowb + (tg >= 0 ? tg : 0)) * MINP; g_i = pr[6144 + h]; g_f = pr[6148 + h]; }
        const int e0 = 16 * wid;
        __syncthreads();
        for (int c = 0; c < 33; ++c) {
            const int t0 = c * 64 - 48;
            if (wid == 0) {
                const int t = t0 + lane; const bool valid = t >= 0;
                const float ig = valid ? bf2f(g_i) + bi : -1e30f;
                const float lf = valid ? logsigmoid(bf2f(g_f) + bfv) : 0.f;
                { const int tn = t + 64; const bf16_t* pr = P + (rowb + (tn < T ? tn : T - 1)) * MINP; g_i = pr[6144 + h]; g_f = pr[6148 + h]; }
                float bc = lf;
#pragma unroll
                for (int o = 1; o < 64; o <<= 1) { const float v = __shfl_up(bc, o); if (lane >= o) bc += v; }
                const float av = ig - bc; float pm = av;
#pragma unroll
                for (int o = 1; o < 64; o <<= 1) { const float v = __shfl_up(pm, o); if (lane >= o) pm = fmaxf(pm, v); }
                const float Mx = fmaxf(m_run, pm), MxL = __shfl(Mx, 63), bL = __shfl(bc, 63);
                fa[lane] = av; fMx[lane] = Mx; fwk[lane] = __expf(av - MxL); fwi[lane] = __expf(m_run - Mx); fef[lane] = __expf(-(bc + Mx)); frs[lane] = 0.f;
                if (lane == 0) fmisc[1] = __expf(m_run - MxL);
                m_run = bL + MxL;
            }
            __syncthreads();
#pragma unroll
            for (int i = 0; i < 4; ++i) { const int ch = tid + 512 * i, l = ch >> 5, cc = ch & 31, t = t0 + l;
                u32x4 qv = {0u, 0u, 0u, 0u}, kv = {0u, 0u, 0u, 0u};
                if (t >= 0) { const bf16_t* pr = P + (rowb + t) * MINP + h * 256 + cc * 8; qv = *(const u32x4*)pr; kv = *(const u32x4*)(pr + 1024); }
                *(LAS u32x4*)(lds + ML_Q + l * 528 + cc * 16) = qv; *(LAS u32x4*)(lds + ML_K + l * 528 + cc * 16) = kv; }
#pragma unroll
            for (int i = 0; i < 4; ++i) { const int ch = tid + 512 * i, l = ch & 63, cc = ch >> 6, t = t0 + l;
                u32x4 kv = {0u, 0u, 0u, 0u};
                if (t >= 0) kv = *(const u32x4*)(P + (rowb + t) * MINP + 1024 + h * 256 + cc * 8);
                const float wk = fwk[l]; LAS bf16_t* dst = (LAS bf16_t*)(lds + ML_KT + (cc * 8) * 144 + l * 2);
                dst[0 * 72] = f2bf1(bflo(kv.x) * wk); dst[1 * 72] = f2bf1(bfhi(kv.x) * wk); dst[2 * 72] = f2bf1(bflo(kv.y) * wk); dst[3 * 72] = f2bf1(bfhi(kv.y) * wk);
                dst[4 * 72] = f2bf1(bflo(kv.z) * wk); dst[5 * 72] = f2bf1(bfhi(kv.z) * wk); dst[6 * 72] = f2bf1(bflo(kv.w) * wk); dst[7 * 72] = f2bf1(bfhi(kv.w) * wk); }
#pragma unroll
            for (int i = 0; i < 2; ++i) { const int ch = tid + 512 * i, l = ch & 63, cc = ch >> 6, t = t0 + l;
                u32x4 vv = {0u, 0u, 0u, 0u};
                if (t >= 0) vv = *(const u32x4*)(P + (rowb + t) * MINP + 2048 + h * 512 + sl * 128 + cc * 8);
                LAS bf16_t* dst = (LAS bf16_t*)(lds + ML_VT + (cc * 8) * 144 + l * 2);
                dst[0 * 72] = (bf16_t)(vv.x & 0xffffu); dst[1 * 72] = (bf16_t)(vv.x >> 16); dst[2 * 72] = (bf16_t)(vv.y & 0xffffu); dst[3 * 72] = (bf16_t)(vv.y >> 16);
                dst[4 * 72] = (bf16_t)(vv.z & 0xffffu); dst[5 * 72] = (bf16_t)(vv.z >> 16); dst[6 * 72] = (bf16_t)(vv.w & 0xffffu); dst[7 * 72] = (bf16_t)(vv.w >> 16); }
            __syncthreads();
            { const int l = tid >> 3, part = tid & 7; float s = 0.f;
#pragma unroll
              for (int i = 0; i < 4; ++i) { const u32x4 qv = *(const LAS u32x4*)(lds + ML_Q + l * 528 + (part * 32 + i * 8) * 2); const LAS float* np = fn + part * 32 + i * 8;
                  s += bflo(qv.x) * np[0] + bfhi(qv.x) * np[1] + bflo(qv.y) * np[2] + bfhi(qv.y) * np[3] + bflo(qv.z) * np[4] + bfhi(qv.z) * np[5] + bflo(qv.w) * np[6] + bfhi(qv.w) * np[7]; }
              s += __shfl_xor(s, 1); s += __shfl_xor(s, 2); s += __shfl_xor(s, 4); if (part == 0) fqn[l] = s; }
            { const int lt = wid >> 1;
#pragma unroll
              for (int s2 = 0; s2 < 2; ++s2) { const int st = (wid & 1) * 2 + s2;
                  if (st <= lt) {
                      f32x4 acc = {0.f, 0.f, 0.f, 0.f};
#pragma unroll
                      for (int ks = 0; ks < 8; ++ks) { const bf16x8 A = *(const LAS bf16x8*)(lds + ML_Q + (16 * lt + fr) * 528 + (32 * ks + fq * 8) * 2);
                          const bf16x8 Bv = *(const LAS bf16x8*)(lds + ML_K + (16 * st + fr) * 528 + (32 * ks + fq * 8) * 2); acc = mfma16(A, Bv, acc); }
                      const int s = 16 * st + fr; const float as = fa[s];
#pragma unroll
                      for (int j = 0; j < 4; ++j) { const int l = 16 * lt + fq * 4 + j; const float e = __expf(as - fMx[l]); float v = (s <= l) ? acc[j] * e : 0.f;
                          *(LAS bf16_t*)(lds + ML_SP + l * 144 + s * 2) = f2bf1(v);
                          v += __shfl_xor(v, 1); v += __shfl_xor(v, 2); v += __shfl_xor(v, 4); v += __shfl_xor(v, 8);
                          if (fr == 0) frs4[l * 4 + st] = v; }
                  } else {
#pragma unroll
                      for (int j = 0; j < 4; ++j) { *(LAS bf16_t*)(lds + ML_SP + (16 * lt + fq * 4 + j) * 144 + (16 * st + fr) * 2) = 0; if (fr == 0) frs4[(16 * lt + fq * 4 + j) * 4 + st] = 0.f; }
                  } } }
            __syncthreads();
            f32x4 o4[4];
#pragma unroll
            for (int lt = 0; lt < 4; ++lt) o4[lt] = (f32x4){0.f, 0.f, 0.f, 0.f};
#pragma unroll
            for (int ks = 0; ks < 8; ++ks) {
                if ((ks & 1) == 0) __builtin_amdgcn_sched_barrier(0);
                u32x4 bw; bw.x = cvt_pk_bf16(C[2 * ks][0], C[2 * ks][1]); bw.y = cvt_pk_bf16(C[2 * ks][2], C[2 * ks][3]); bw.z = cvt_pk_bf16(C[2 * ks + 1][0], C[2 * ks + 1][1]); bw.w = cvt_pk_bf16(C[2 * ks + 1][2], C[2 * ks + 1][3]);
                const bf16x8 Bf = __builtin_bit_cast(bf16x8, bw);
#pragma unroll
                for (int lt = 0; lt < 4; ++lt) { const LAS unsigned char* qp = lds + ML_Q + (16 * lt + fr) * 528 + (32 * ks + fq * 4) * 2;
                    const bf16x8 A = cat8(*(const LAS u32x2*)qp, *(const LAS u32x2*)(qp + 32)); o4[lt] = mfma16(A, Bf, o4[lt]); }
            }
#pragma unroll
            for (int lt = 0; lt < 4; ++lt)
#pragma unroll
                for (int j = 0; j < 4; ++j) o4[lt][j] *= fwi[16 * lt + fq * 4 + j];
            bf16x8 Bv[2];
#pragma unroll
            for (int ks = 0; ks < 2; ++ks) { Bv[ks] = *(const LAS bf16x8*)(lds + ML_VT + (e0 + fr) * 144 + (32 * ks + fq * 8) * 2);
#pragma unroll
                for (int lt = 0; lt < 4; ++lt) { const bf16x8 A = *(const LAS bf16x8*)(lds + ML_SP + (16 * lt + fr) * 144 + (32 * ks + fq * 8) * 2); o4[lt] = mfma16(A, Bv[ks], o4[lt]); } }
#pragma unroll
            for (int lt = 0; lt < 4; ++lt)
#pragma unroll
                for (int j = 0; j < 4; ++j) *(LAS float*)(lds + ML_K + (16 * lt + fq * 4 + j) * 528 + (e0 + fr) * 4) = o4[lt][j];
            __builtin_amdgcn_sched_barrier(0);
            const float decay = fmisc[1];
#pragma unroll
            for (int mt = 0; mt < 16; ++mt) { if ((mt & 3) == 0) __builtin_amdgcn_sched_barrier(0); C[mt] *= decay;
#pragma unroll
                for (int ks = 0; ks < 2; ++ks) { const bf16x8 A = *(const LAS bf16x8*)(lds + ML_KT + (16 * mt + fr) * 144 + (32 * ks + fq * 8) * 2); C[mt] = mfma16(A, Bv[ks], C[mt]); } }
            if (tid < 64) { const float den = fwi[tid] * fqn[tid] + ((frs4[tid * 4] + frs4[tid * 4 + 1]) + (frs4[tid * 4 + 2] + frs4[tid * 4 + 3])); fsc[tid] = 1.0f / fmaxf(fabsf(den), fef[tid]); }
            if (tid < 256) { float s = 0.f;
#pragma unroll
                for (int i = 0; i < 8; ++i) { const u32x4 kv = *(const LAS u32x4*)(lds + ML_KT + tid * 144 + i * 16);
                    s += (bflo(kv.x) + bfhi(kv.x)) + (bflo(kv.y) + bfhi(kv.y)) + (bflo(kv.z) + bfhi(kv.z)) + (bflo(kv.w) + bfhi(kv.w)); }
                fn[tid] = decay * fn[tid] + s; }
            __syncthreads();
#pragma unroll
            for (int i = 0; i < 2; ++i) { const int ch = tid + 512 * i, l = ch >> 4, cc = ch & 15, t = t0 + l;
                const float sc = fsc[l];
                const f32x4 v0 = *(const LAS f32x4*)(lds + ML_K + l * 528 + cc * 32), v1 = *(const LAS f32x4*)(lds + ML_K + l * 528 + cc * 32 + 16);
                u32x4 w; w.x = cvt_pk_bf16(v0[0] * sc, v0[1] * sc); w.y = cvt_pk_bf16(v0[2] * sc, v0[3] * sc); w.z = cvt_pk_bf16(v1[0] * sc, v1[1] * sc); w.w = cvt_pk_bf16(v1[2] * sc, v1[3] * sc);
                if (t >= 0) *(u32x4*)(Hout + (rowb + t) * ldh + h * 512 + sl * 128 + cc * 8) = w; }
        }
    }
}
template <int NS>
__device__ __forceinline__ void tail_fixup_phase(LAS unsigned char* lds, bf16_t* hb, const float* ssq_next, float* rstd_next, float* fout, float scale, const float* part) {
    const int tid = threadIdx.x, lane = tid & 63, wid = tid >> 6;
    LAS float* red = (LAS float*)lds;
    for (int rl = blockIdx.x; rl < 256; rl += gridDim.x) {
        const int pn = wid, row = M - 256 + rl, col = pn * 256 + lane * 4;
        f32x4 pv[NS];
#pragma unroll
        for (int sl = 0; sl < NS; ++sl) pv[sl] = *(const f32x4*)(part + ((size_t)(pn * NS + sl) * 256 + rl) * 256 + lane * 4);
        const u32x2 hv = *(const u32x2*)(hb + (size_t)row * D + col);
        f32x4 s = {0.f, 0.f, 0.f, 0.f};
#pragma unroll
        for (int sl = 0; sl < NS; ++sl) s += pv[sl];
        f32x4 h = {bflo(hv.x), bfhi(hv.x), bflo(hv.y), bfhi(hv.y)}; h += s * scale;
        if (fout) { const int b = row / T, t = row - b * T; if (t >= NMETA) *(f32x4*)(fout + ((size_t)b * SEQ + (t - NMETA)) * D + col) = h; }
        else { u32x2 w; w.x = cvt_pk_bf16(h[0], h[1]); w.y = cvt_pk_bf16(h[2], h[3]); *(u32x2*)(hb + (size_t)row * D + col) = w;
            float ss = (h[0] * h[0] + h[1] * h[1]) + (h[2] * h[2] + h[3] * h[3]); ss = wave_sum(ss);
            __syncthreads(); if (lane == 0) red[wid] = ss; __syncthreads();
            if (tid == 0) { const float tot = ((red[0] + red[1]) + (red[2] + red[3])) + ((red[4] + red[5]) + (red[6] + red[7])); rstd_next[row] = __builtin_amdgcn_rsqf(tot * (1.0f / D) + EPS); } }
    }
    if (!fout) for (int r = blockIdx.x * NTHREADS + tid; r < M - 256; r += gridDim.x * NTHREADS) {
        const f32x4* p = (const f32x4*)(ssq_next + (size_t)r * 32); float s = 0.f;
#pragma unroll
        for (int i = 0; i < 8; ++i) { const f32x4 v = p[i]; s += (v[0] + v[1]) + (v[2] + v[3]); }
        rstd_next[r] = __builtin_amdgcn_rsqf(s * (1.0f / D) + EPS);
    }
}
__device__ __forceinline__ void mlstm_y_phase(bf16_t* P, const float* g_head) {
    const int tid = threadIdx.x, lane = tid & 63, wid = tid >> 6;
    const int gw = blockIdx.x * 8 + wid, NGW = gridDim.x * 8;
    for (int it0 = gw * 4; it0 < M * 4; it0 += NGW * 4) {
        const int row = it0 >> 2; bf16_t* base = P + (size_t)row * MINP + lane * 8;
        u32x4 hv[4], ov[4];
#pragma unroll
        for (int h = 0; h < 4; ++h) { hv[h] = *(const u32x4*)(base + 2048 + h * 512); ov[h] = *(const u32x4*)(base + 4096 + h * 512); }
        float ss[4];
#pragma unroll
        for (int h = 0; h < 4; ++h) { const float a0 = bflo(hv[h].x), a1 = bfhi(hv[h].x), a2 = bflo(hv[h].y), a3 = bfhi(hv[h].y), a4 = bflo(hv[h].z), a5 = bfhi(hv[h].z), a6 = bflo(hv[h].w), a7 = bfhi(hv[h].w);
            ss[h] = (a0 * a0 + a1 * a1) + (a2 * a2 + a3 * a3) + (a4 * a4 + a5 * a5) + (a6 * a6 + a7 * a7); }
#pragma unroll
        for (int o = 1; o < 64; o <<= 1) {
#pragma unroll
            for (int h = 0; h < 4; ++h) ss[h] += __shfl_xor(ss[h], o); }
#pragma unroll
        for (int h = 0; h < 4; ++h) {
            const float rs = __builtin_amdgcn_rsqf(ss[h] * (1.0f / 512.0f) + EPS);
            float x[8] = {bflo(hv[h].x), bfhi(hv[h].x), bflo(hv[h].y), bfhi(hv[h].y), bflo(hv[h].z), bfhi(hv[h].z), bflo(hv[h].w), bfhi(hv[h].w)};
            const float o[8] = {bflo(ov[h].x), bfhi(ov[h].x), bflo(ov[h].y), bfhi(ov[h].y), bflo(ov[h].z), bfhi(ov[h].z), bflo(ov[h].w), bfhi(ov[h].w)};
            const f32x4 g0 = *(const f32x4*)(g_head + h * 512 + lane * 8), g1 = *(const f32x4*)(g_head + h * 512 + lane * 8 + 4);
            const float g[8] = {g0[0], g0[1], g0[2], g0[3], g1[0], g1[1], g1[2], g1[3]};
#pragma unroll
            for (int i = 0; i < 8; ++i) x[i] = x[i] * rs * g[i] * __builtin_amdgcn_rcpf(1.0f + __builtin_amdgcn_exp2f(-1.4426950408889634f * o[i]));
            u32x4 w; w.x = cvt_pk_bf16(x[0], x[1]); w.y = cvt_pk_bf16(x[2], x[3]); w.z = cvt_pk_bf16(x[4], x[5]); w.w = cvt_pk_bf16(x[6], x[7]);
            *(u32x4*)(base + 2048 + h * 512) = w;
        }
    }
}
__device__ __forceinline__ float rope_inv(int i) {
    constexpr float tab[16] = {1.000000000e+00f, 4.403665960e-01f, 1.939227432e-01f, 8.539710194e-02f, 3.760603070e-02f, 1.656044088e-02f, 7.292664610e-03f, 3.211446106e-03f,
                               1.414213562e-03f, 6.227724371e-04f, 2.742481884e-04f, 1.207697351e-04f, 5.318295734e-05f, 2.341999971e-05f, 1.031338525e-05f, 4.541670478e-06f};
    return tab[i];
}
template <int DPL>
__device__ __forceinline__ void rope_ld(const bf16_t* ptr, bool active, u32x4 (&raw)[DPL / 8]) {
#pragma unroll
    for (int i = 0; i < DPL / 8; ++i) { raw[i] = (u32x4){0u, 0u, 0u, 0u}; if (active) raw[i] = *(const u32x4*)(ptr + 8 * i); }
}
template <int DPL, bool NORM>
__device__ __forceinline__ void rope_apply(const u32x4 (&raw)[DPL / 8], bf16_t* ptr, bool active, const float* gain, float post, float pos, int quarter) {
    float x[DPL];
#pragma unroll
    for (int i = 0; i < DPL / 8; ++i) { const u32x4 v = raw[i];
        x[8 * i + 0] = bflo(v.x); x[8 * i + 1] = bfhi(v.x); x[8 * i + 2] = bflo(v.y); x[8 * i + 3] = bfhi(v.y); x[8 * i + 4] = bflo(v.z); x[8 * i + 5] = bfhi(v.z); x[8 * i + 6] = bflo(v.w); x[8 * i + 7] = bfhi(v.w); }
    if (NORM) { float ss = 0.f;
#pragma unroll
        for (int i = 0; i < DPL; ++i) ss += x[i] * x[i];
        ss += __shfl_xor(ss, 1); ss += __shfl_xor(ss, 2); const float rs = __builtin_amdgcn_rsqf(ss * (1.0f / (4 * DPL)) + EPS);
#pragma unroll
        for (int i = 0; i < DPL / 4; ++i) { const f32x4 g = *(const f32x4*)(gain + 4 * i); x[4 * i] *= rs * g[0]; x[4 * i + 1] *= rs * g[1]; x[4 * i + 2] *= rs * g[2]; x[4 * i + 3] *= rs * g[3]; } }
    if (quarter == 0) {
#pragma unroll
        for (int i = 0; i < DPL / 2; ++i) { const float ang = pos * rope_inv(i * (32 / DPL)); const float n = rintf(ang * 0.15915494309189535f);
            float r = fmaf(-n, 6.28125f, ang); r = fmaf(-n, 1.9353071795864769e-3f, r); const float sn = __sinf(r), cs = __cosf(r);
            const float x1 = x[i], x2 = x[i + DPL / 2]; x[i] = x1 * cs - x2 * sn; x[i + DPL / 2] = x2 * cs + x1 * sn; } }
    if (active) {
#pragma unroll
        for (int i = 0; i < DPL / 8; ++i) { u32x4 w; w.x = cvt_pk_bf16(x[8 * i] * post, x[8 * i + 1] * post); w.y = cvt_pk_bf16(x[8 * i + 2] * post, x[8 * i + 3] * post);
            w.z = cvt_pk_bf16(x[8 * i + 4] * post, x[8 * i + 5] * post); w.w = cvt_pk_bf16(x[8 * i + 6] * post, x[8 * i + 7] * post); *(u32x4*)(ptr + 8 * i) = w; } }
}
__device__ __forceinline__ void dsa_post_phase(bf16_t* P, bf16_t* vT, bf16_t* kiC, const float* g_q, const float* g_k) {
    const int tid = threadIdx.x, lane = tid & 63, wid = tid >> 6, head = lane >> 2, quarter = lane & 3;
    const int gw = blockIdx.x * 8 + wid, NGW = gridDim.x * 8;
    for (int unit = blockIdx.x; unit < NB * 33; unit += gridDim.x) {
        const int b = unit / 33, tile = unit - b * 33, t0 = tile * 64;
        const int gd = tid, g = gd >> 7, d = gd & 127; bf16_t* dst = vT + ((size_t)(b * 4 + g) * 128 + d) * TP + t0;
#pragma unroll
        for (int l8 = 0; l8 < 8; ++l8) { unsigned short v[8];
#pragma unroll
            for (int e = 0; e < 8; ++e) { const int t = t0 + 8 * l8 + e; v[e] = t < T ? P[((size_t)b * T + t) * AINP + 2560 + gd] : (unsigned short)0; }
            u32x4 w; w.x = v[0] | ((unsigned)v[1] << 16); w.y = v[2] | ((unsigned)v[3] << 16); w.z = v[4] | ((unsigned)v[5] << 16); w.w = v[6] | ((unsigned)v[7] << 16);
            *(u32x4*)(dst + 8 * l8) = w; }
    }
    for (int r = gw; r < M; r += NGW) {
        const int b = r / T, t = r - b * T; bf16_t* base = P + (size_t)r * AINP; const float pos = (float)t;
        bf16_t* pq = base + head * 128 + quarter * 32; bf16_t* pk = base + 2048 + (head & 3) * 128 + quarter * 32; bf16_t* pqi = base + 3072 + head * 64 + quarter * 16; bf16_t* pki = base + 4096 + quarter * 16;
        u32x4 rq[4], rk[4], rqi[2], rki[2];
        rope_ld<32>(pq, true, rq); rope_ld<32>(pk, lane < 16, rk); rope_ld<16>(pqi, true, rqi); rope_ld<16>(pki, lane < 4, rki);
        const unsigned short wraw = lane < 16 ? base[4160 + lane] : (unsigned short)0;
        rope_apply<32, true>(rq, pq, true, g_q + quarter * 32, 0.08838834764831845f * 1.4426950408889634f, pos, quarter);
        rope_apply<32, true>(rk, pk, lane < 16, g_k + quarter * 32, 1.0f, pos, quarter);
        rope_apply<16, false>(rqi, pqi, true, nullptr, 1.0f, pos, quarter);
        rope_apply<16, false>(rki, kiC + (size_t)r * 64 + quarter * 16, lane < 4, nullptr, 1.0f, pos, quarter);
        if (lane < 16) base[4160 + lane] = f2bf1(bf2f(wraw) * 0.03125f);
    }
}
__device__ __forceinline__ unsigned wave_count(int c) {
#pragma unroll
    for (int o = 1; o < 64; o <<= 1) c += __shfl_xor(c, o);
    return (unsigned)c;
}
constexpr int TK_SC = 0, TK_KB = 69632, TK_KBUF = 18432;
__device__ __forceinline__ void dsa_topk_phase(LAS unsigned char* lds, const bf16_t* P, const bf16_t* kiC, unsigned* mask) {
    const int tid = threadIdx.x, lane = tid & 63, wid = __builtin_amdgcn_readfirstlane(tid >> 6), fr = lane & 15, fq = lane >> 4;
    LAS float* sc = (LAS float*)(lds + TK_SC + wid * 8704);
    for (int rnd = 0; rnd * (int)gridDim.x < NB * 258; ++rnd) {
        const int unit = rnd * (int)gridDim.x + ((rnd & 1) ? (int)gridDim.x - 1 - (int)blockIdx.x : (int)blockIdx.x); if (unit >= NB * 258) continue;
        const int g8 = 257 - unit / NB, b = unit % NB;
        const int t = 8 * g8 + wid; const size_t row = (size_t)b * T + t; const bf16_t* base = P + row * AINP;
        const bf16x8 A0 = *(const bf16x8*)(base + 3072 + fr * 64 + fq * 8), A1 = *(const bf16x8*)(base + 3072 + fr * 64 + 32 + fq * 8);
        const u32x2 wv = *(const u32x2*)(base + 4160 + fq * 4); const bf16x4 Wf = __builtin_bit_cast(bf16x4, wv);
        const int nk8 = ((8 * g8 + 7) >> 7) + 1;
        u32x4 pf[2];
#define TK_FETCH(k8_) do { _Pragma("unroll") for (int i = 0; i < 2; ++i) { const int ch = tid + 512 * i; int key = 128 * (k8_) + (ch >> 3); key = key < T ? key : T - 1; \
            pf[i] = *(const u32x4*)(kiC + ((size_t)b * T + key) * 64 + (ch & 7) * 8); } } while (0)
#define TK_PUT(buf_) do { _Pragma("unroll") for (int i = 0; i < 2; ++i) { const int ch = tid + 512 * i; *(LAS u32x4*)(lds + TK_KB + (buf_) * TK_KBUF + (ch >> 3) * 144 + (ch & 7) * 16) = pf[i]; } } while (0)
        __syncthreads();
        TK_FETCH(0); TK_PUT(0);
        __syncthreads();
        for (int k8 = 0; k8 < nk8; ++k8) {
            const LAS unsigned char* kb = lds + TK_KB + (k8 & 1) * TK_KBUF + fr * 144 + fq * 16;
            if (k8 + 1 < nk8) TK_FETCH(k8 + 1);
            float v[8];
#pragma unroll
            for (int i = 0; i < 8; ++i) { const bf16x8 B0 = *(const LAS bf16x8*)(kb + i * 16 * 144), B1 = *(const LAS bf16x8*)(kb + i * 16 * 144 + 64);
                f32x4 acc = {0.f, 0.f, 0.f, 0.f}; acc = mfma16(A0, B0, acc); acc = mfma16(A1, B1, acc);
                const float inf = __builtin_inff(); u32x2 pw;
                pw.x = cvt_pk_bf16(__builtin_amdgcn_fmed3f(acc[0], 0.f, inf), __builtin_amdgcn_fmed3f(acc[1], 0.f, inf)); pw.y = cvt_pk_bf16(__builtin_amdgcn_fmed3f(acc[2], 0.f, inf), __builtin_amdgcn_fmed3f(acc[3], 0.f, inf));
                const f32x4 d = __builtin_amdgcn_mfma_f32_16x16x16bf16_1k(Wf, __builtin_bit_cast(bf16x4, pw), (f32x4){0.f, 0.f, 0.f, 0.f}, 0, 0, 0);
                v[i] = d[0]; }
            sc[128 * k8 + lane] = fq == 0 ? v[0] : (fq == 1 ? v[1] : (fq == 2 ? v[2] : v[3]));
            sc[128 * k8 + 64 + lane] = fq == 0 ? v[4] : (fq == 1 ? v[5] : (fq == 2 ? v[6] : v[7]));
            if (k8 + 1 < nk8) TK_PUT((k8 + 1) & 1);
            __syncthreads();
        }
#undef TK_FETCH
#undef TK_PUT
        unsigned u[33];
#pragma unroll
        for (int c = 0; c < 33; ++c) { const int key = 64 * c + lane; unsigned bits = 0u;
            if (key <= t) { const unsigned f = __builtin_bit_cast(unsigned, sc[key]); bits = (f & 0x80000000u) ? ~f : (f | 0x80000000u); }
            u[c] = bits; }
        unsigned long long* mrow = (unsigned long long*)(mask + row * 66);
        if (t < 256) {
#pragma unroll
            for (int c = 0; c < 33; ++c) { const unsigned long long bal = __ballot(64 * c + lane <= t); if (lane == 0) mrow[c] = bal; }
        } else {
            unsigned th = 0u; bool exact = false;
            for (int bit = 31; bit >= 0; --bit) { const unsigned cand = th | (1u << bit); unsigned cnt = 0u;
#pragma unroll
                for (int c = 0; c < 33; ++c) cnt += (unsigned)__popcll(__ballot(u[c] >= cand));
                if (cnt >= 256u) { th = cand; if (cnt == 256u) { exact = true; break; } } }
            unsigned need = 0u;
            if (!exact) { unsigned cgt = 0u;
#pragma unroll
                for (int c = 0; c < 33; ++c) cgt += (unsigned)__popcll(__ballot(u[c] > th));
                need = 256u - cgt; }
            unsigned seen = 0u;
            const unsigned long long lt_mask = (1ull << lane) - 1ull;
#pragma unroll
            for (int c = 0; c < 33; ++c) { const bool eq = !exact && (u[c] == th), gt = exact ? (u[c] >= th) : (u[c] > th); const unsigned long long beq = __ballot(eq);
                const unsigned rank = seen + (unsigned)__popcll(beq & lt_mask); const bool sel = gt || (eq && rank < need);
                seen += (unsigned)__popcll(beq); const unsigned long long bal = __ballot(sel); if (lane == 0) mrow[c] = bal; }
        }
    }
}
constexpr int AT_K = 0, AT_V = 17408, AT_BUF = 35840;
__device__ __forceinline__ void dsa_attn_phase(LAS unsigned char* lds, const bf16_t* P, bf16_t* Oout, int ldo, const bf16_t* vT, const unsigned* mask) {
    const int tid = threadIdx.x, lane = tid & 63, wid = __builtin_amdgcn_readfirstlane(tid >> 6), fr = lane & 15, fq = lane >> 4;
    const int qt = wid & 3, rp = wid >> 2;
    for (int rnd = 0; rnd * (int)gridDim.x < 33 * 64; ++rnd) {
        const int unit = rnd * (int)gridDim.x + ((rnd & 1) ? (int)gridDim.x - 1 - (int)blockIdx.x : (int)blockIdx.x); if (unit >= 33 * 64) continue;
        const int qb = 32 - unit / 64, bg = unit % 64, b = bg >> 2, g = bg & 3;
        const int tq = 64 * qb + 16 * qt + fr, tqc = tq < T ? tq : T - 1; const size_t rowq = (size_t)b * T + tqc;
        bf16x8 Qf[2][4];
#pragma unroll
        for (int hh = 0; hh < 2; ++hh)
#pragma unroll
            for (int ks = 0; ks < 4; ++ks) Qf[hh][ks] = *(const bf16x8*)(P + rowq * AINP + (g * 4 + rp * 2 + hh) * 128 + 32 * ks + fq * 8);
        f32x4 O[8][2];
#pragma unroll
        for (int dt = 0; dt < 8; ++dt) { O[dt][0] = (f32x4){0.f, 0.f, 0.f, 0.f}; O[dt][1] = (f32x4){0.f, 0.f, 0.f, 0.f}; }
        float mx[2] = {-1e30f, -1e30f}, ls[2] = {0.f, 0.f};
        const unsigned long long* mrow = (const unsigned long long*)(mask + rowq * 66);
        u32x4 pk[2], pv[2];
#define AT_FETCH(kt_) do { _Pragma("unroll") for (int i = 0; i < 2; ++i) { const int ch = tid + 512 * i; { const int l = ch >> 4, cc = ch & 15; int key = 64 * (kt_) + l; key = key < T ? key : T - 1; \
            pk[i] = *(const u32x4*)(P + ((size_t)b * T + key) * AINP + 2048 + g * 128 + cc * 8); } \
            { const int d = ch >> 3, cc = ch & 7; pv[i] = *(const u32x4*)(vT + ((size_t)(b * 4 + g) * 128 + d) * TP + 64 * (kt_) + cc * 8); } } } while (0)
#define AT_PUT(buf_) do { _Pragma("unroll") for (int i = 0; i < 2; ++i) { const int ch = tid + 512 * i; *(LAS u32x4*)(lds + (buf_) * AT_BUF + AT_K + (ch >> 4) * 272 + (ch & 15) * 16) = pk[i]; \
            *(LAS u32x4*)(lds + (buf_) * AT_BUF + AT_V + (ch >> 3) * 144 + (ch & 7) * 16) = pv[i]; } } while (0)
        __syncthreads();
        AT_FETCH(0); AT_PUT(0);
        unsigned long long mw_next = mrow[0];
        __syncthreads();
        for (int kt64 = 0; kt64 <= qb; ++kt64) {
            const LAS unsigned char* lb = lds + (kt64 & 1) * AT_BUF;
            const unsigned long long mw = mw_next;
            if (kt64 < qb) { AT_FETCH(kt64 + 1); mw_next = mrow[kt64 + 1]; }
            f32x4 S[2][4];
#pragma unroll
            for (int kt = 0; kt < 4; ++kt) { S[0][kt] = (f32x4){0.f, 0.f, 0.f, 0.f}; S[1][kt] = (f32x4){0.f, 0.f, 0.f, 0.f};
#pragma unroll
                for (int ks = 0; ks < 4; ++ks) { const bf16x8 A = *(const LAS bf16x8*)(lb + AT_K + (16 * kt + fr) * 272 + (32 * ks + fq * 8) * 2);
                    S[0][kt] = mfma16(A, Qf[0][ks], S[0][kt]); S[1][kt] = mfma16(A, Qf[1][ks], S[1][kt]); } }
            bf16x8 Pf[2][2]; float alpha[2];
#pragma unroll
            for (int hh = 0; hh < 2; ++hh) {
                float tmax = -__builtin_inff();
#pragma unroll
                for (int kt = 0; kt < 4; ++kt)
#pragma unroll
                    for (int j = 0; j < 4; ++j) { const bool bit = (mw >> (16 * kt + fq * 4 + j)) & 1ull; S[hh][kt][j] = bit ? S[hh][kt][j] : -__builtin_inff(); tmax = fmaxf(tmax, S[hh][kt][j]); }
                tmax = fmaxf(tmax, __shfl_xor(tmax, 16)); tmax = fmaxf(tmax, __shfl_xor(tmax, 32));
                const float mnew = fmaxf(mx[hh], tmax); alpha[hh] = __builtin_amdgcn_exp2f(mx[hh] - mnew); mx[hh] = mnew;
                float psum = 0.f;
#pragma unroll
                for (int kt = 0; kt < 4; ++kt)
#pragma unroll
                    for (int j = 0; j < 4; ++j) { S[hh][kt][j] = __builtin_amdgcn_exp2f(S[hh][kt][j] - mnew); psum += S[hh][kt][j]; }
                ls[hh] = ls[hh] * alpha[hh] + psum;
#pragma unroll
                for (int kk = 0; kk < 2; ++kk) { u32x4 w; w.x = cvt_pk_bf16(S[hh][2 * kk][0], S[hh][2 * kk][1]); w.y = cvt_pk_bf16(S[hh][2 * kk][2], S[hh][2 * kk][3]);
                    w.z = cvt_pk_bf16(S[hh][2 * kk + 1][0], S[hh][2 * kk + 1][1]); w.w = cvt_pk_bf16(S[hh][2 * kk + 1][2], S[hh][2 * kk + 1][3]); Pf[hh][kk] = __builtin_bit_cast(bf16x8, w); }
            }
#pragma unroll
            for (int dt = 0; dt < 8; ++dt) { O[dt][0] *= alpha[0]; O[dt][1] *= alpha[1];
#pragma unroll
                for (int kk = 0; kk < 2; ++kk) { const LAS unsigned char* vp = lb + AT_V + (16 * dt + fr) * 144 + (32 * kk + fq * 4) * 2;
                    const bf16x8 A = cat8(*(const LAS u32x2*)vp, *(const LAS u32x2*)(vp + 32));
                    O[dt][0] = mfma16(A, Pf[0][kk], O[dt][0]); O[dt][1] = mfma16(A, Pf[1][kk], O[dt][1]); } }
            if (kt64 < qb) AT_PUT((kt64 + 1) & 1);
            __syncthreads();
        }
#undef AT_FETCH
#undef AT_PUT
#pragma unroll
        for (int hh = 0; hh < 2; ++hh) { float l = ls[hh]; l += __shfl_xor(l, 16); l += __shfl_xor(l, 32); const float inv = 1.0f / l;
            if (tq < T) {
#pragma unroll
                for (int dt = 0; dt < 8; ++dt) { u32x2 w; w.x = cvt_pk_bf16(O[dt][hh][0] * inv, O[dt][hh][1] * inv); w.y = cvt_pk_bf16(O[dt][hh][2] * inv, O[dt][hh][3] * inv);
                    *(u32x2*)(Oout + rowq * ldo + (g * 4 + rp * 2 + hh) * 128 + 16 * dt + fq * 4) = w; } } }
    }
}
constexpr int N_PHASES = 18;
__global__ void __launch_bounds__(NTHREADS, 2) mega_fwd(Args a) {
    extern __shared__ __attribute__((aligned(16))) unsigned char lds_raw[];
    LAS unsigned char* lds = (LAS unsigned char*)lds_raw;
    cg::grid_group grid = cg::this_grid();
    volatile LAS unsigned* bst = (volatile LAS unsigned*)(lds + LDS_BYTES - 64);
    if (threadIdx.x == 0) { bst[0] = 0u; bst[1] = 0u; }
    __syncthreads();
    const XcdBarrier xbar = xcd_barrier_post((unsigned*)(a.ws + WS_BAR), bst);
    unsigned char* ws = a.ws;
    bf16_t* hb = (bf16_t*)(ws + WS_HB); bf16_t* P = (bf16_t*)(ws + WS_P); float* ssq = (float*)(ws + WS_SSQ); float* rstd = (float*)(ws + WS_RSTD);
    unsigned* mask = (unsigned*)(ws + WS_MASK); bf16_t* vT = (bf16_t*)(ws + WS_VT); float* part = (float*)(ws + WS_PART); bf16_t* kiC = (bf16_t*)(ws + WS_KIC);
    const int lo = a.ph_lo, hi = a.ph_hi;
    const int G = (int)gridDim.x, cidx = (int)blockIdx.x;
#ifndef PHMASK
#define PHMASK 0x3ffff
#endif
#define IN(k) ((((PHMASK) >> (k)) & 1) && lo <= (k) && (k) < hi)
#define GSYNC() xcd_barrier(xbar)
#define SEAM(k) do { if (IN(k) && IN((k) + 1)) GSYNC(); } while (0)
#define GEMM_GU(k, f, sidx) if (IN(k)) { pg8::Gemm g{hb, (const bf16_t*)(ws + WS_GU + (size_t)(f) * SZ_GU), M, 2 * FF, D, D}; pg8::StaticOrder S; S.init(M, 2 * FF, D, G, cidx); \
        pg8::EpiSwiglu E{P, rstd + (size_t)(sidx) * M}; pg8::gemm_phase<pg8::EpiSwiglu, pg8::StaticOrder, true, true>(lds, g, S, E); } SEAM(k)
#define GEMM_DN(k, f, snext) if (IN(k)) { pg8::Gemm g{P, (const bf16_t*)(ws + WS_DN + (size_t)(f) * SZ_DN), M, D, FF, FF}; pg8::TailOrder S; S.init(M, D, FF, 22, G, cidx); \
        float* sn_ = ssq + (size_t)((snext) >= 0 ? (snext) : 0) * M * 32; float* fo_ = (snext) >= 0 ? nullptr : a.out; \
        pg8::EpiResid E{hb, sn_, fo_, 0.5f, part, 22}; pg8::gemm_phase<pg8::EpiResid, pg8::TailOrder, true, true>(lds, g, S, E); \
        GSYNC(); tail_fixup_phase<22>(lds, hb, sn_, rstd + (size_t)((snext) >= 0 ? (snext) : 0) * M, fo_, 0.5f, part); } SEAM(k)
#define GEMM_OUT(k, Aptr, lda_, Wofs, sidx) if (IN(k)) { pg8::Gemm g{Aptr, (const bf16_t*)(ws + (Wofs)), M, D, D, lda_}; pg8::TailOrder S; S.init(M, D, D, 16, G, cidx); \
        float* sn_ = ssq + (size_t)(sidx) * M * 32; \
        pg8::EpiResid E{hb, sn_, nullptr, 1.0f, part, 16}; pg8::gemm_phase<pg8::EpiResid, pg8::TailOrder, true, true>(lds, g, S, E); \
        GSYNC(); tail_fixup_phase<16>(lds, hb, sn_, rstd + (size_t)(sidx) * M, nullptr, 1.0f, part); } SEAM(k)

    if (IN(0)) prologue_phase(lds, a);
#ifdef DUP_PRO
    if (IN(0)) { __syncthreads(); prologue_phase(lds, a); }
#endif
    if (IN(0) && IN(1)) grid.sync();
#ifdef DUP_SYNC
    for (int i_ = 0; i_ < 20; ++i_) GSYNC();
#endif
    GEMM_GU(1, 0, 0);
    GEMM_DN(2, 0, 1);
    if (IN(3)) { pg8::Gemm g{hb, (const bf16_t*)(ws + WS_MIN), M, MINP, D, D}; pg8::StaticOrder S; S.init(M, MINP, D, G, cidx);
        pg8::EpiRowScale E{P, MINP, rstd + (size_t)1 * M}; pg8::gemm_phase<pg8::EpiRowScale, pg8::StaticOrder, true, true>(lds, g, S, E); }
    SEAM(3);
#ifdef DUP_SCAN
    if (IN(4)) { mlstm_scan_phase(lds, P, hb, D, a.in[12], a.in[13]); __syncthreads(); }
#endif
    if (IN(4)) mlstm_scan_phase(lds, P, P + 2048, MINP, a.in[12], a.in[13]);
    SEAM(4);
    if (IN(5)) mlstm_y_phase(P, a.in[14]);
    SEAM(5);
    GEMM_OUT(6, P + 2048, MINP, WS_MOUT, 2);
    GEMM_GU(7, 1, 2);
    GEMM_DN(8, 1, 3);
    GEMM_GU(9, 2, 3);
    GEMM_DN(10, 2, 4);
    if (IN(11)) { pg8::Gemm g{hb, (const bf16_t*)(ws + WS_AIN), M, AINP, D, D}; pg8::StaticOrder S; S.init(M, AINP, D, G, cidx);
        pg8::EpiRowScale E{P, AINP, rstd + (size_t)4 * M}; pg8::gemm_phase<pg8::EpiRowScale, pg8::StaticOrder, true, true>(lds, g, S, E); }
    SEAM(11);
    if (IN(12)) dsa_post_phase(P, vT, kiC, a.in[17], a.in[18]);
    SEAM(12);
    if (IN(13)) dsa_topk_phase(lds, P, kiC, mask);
#ifdef DUP_TOPK
    if (IN(13)) { __syncthreads(); dsa_topk_phase(lds, P, kiC, mask); }
#endif
    SEAM(13);
#ifdef DUP_ATTN
    if (IN(14)) { dsa_attn_phase(lds, P, hb, D, vT, mask); __syncthreads(); }
#endif
    if (IN(14)) dsa_attn_phase(lds, P, P, AINP, vT, mask);
    SEAM(14);
    GEMM_OUT(15, P, AINP, WS_AOUT, 5);
    GEMM_GU(16, 3, 5);
    GEMM_DN(17, 3, -1);
#undef IN
#undef SEAM
}

extern "C" void kernel_launch(void* const* d_in, const int* in_sizes, int n_in, void* d_out, int out_size, void* d_ws, size_t ws_size, hipStream_t stream) {
    static int grid = 0;
    if (grid == 0) {
        if (n_in != 20 || out_size != NB * SEQ * D || ws_size < WS_END) { fprintf(stderr, "kernel_launch: unexpected problem: n_in %d out %d ws %zu (need %zu)\n", n_in, out_size, ws_size, (size_t)WS_END); grid = -1; return; }
        int dev = 0, cus = 0, per_cu = 0;
        if (hipGetDevice(&dev) != hipSuccess || hipDeviceGetAttribute(&cus, hipDeviceAttributeMultiprocessorCount, dev) != hipSuccess) { fprintf(stderr, "kernel_launch: device query failed\n"); grid = -1; return; }
        if (hipFuncSetAttribute((const void*)mega_fwd, hipFuncAttributeMaxDynamicSharedMemorySize, LDS_BYTES) != hipSuccess) { fprintf(stderr, "kernel_launch: hipFuncSetAttribute failed\n"); grid = -1; return; }
        if (hipOccupancyMaxActiveBlocksPerMultiprocessor(&per_cu, (const void*)mega_fwd, NTHREADS, LDS_BYTES) != hipSuccess || per_cu < 1) { fprintf(stderr, "kernel_launch: occupancy query gave %d\n", per_cu); per_cu = 1; }
        (void)hipGetLastError();
        grid = cus;
    }
    if (grid < 0) return;
    if (hipMemsetAsync((char*)d_ws + WS_BAR, 0, 16384, stream) != hipSuccess) { fprintf(stderr, "kernel_launch: memset of the barrier words failed\n"); return; }
    Args a{};
    for (int i = 0; i < 20; ++i) a.in[i] = (const float*)d_in[i];
    a.out = (float*)d_out; a.ws = (unsigned char*)d_ws;
    a.ph_lo = 0; a.ph_hi = N_PHASES;
    void* args[] = {&a};
    const hipError_t e = hipLaunchCooperativeKernel((const void*)mega_fwd, dim3(grid), dim3(NTHREADS), args, LDS_BYTES, stream);
    if (e != hipSuccess) fprintf(stderr, "kernel_launch: cooperative launch failed: %s (grid %d)\n", hipGetErrorString(e), grid);
}
```

```cpp
#include <hip/hip_runtime.h>
#include <hip/hip_cooperative_groups.h>
#include <cstdio>
#include <cstdint>
namespace cg = cooperative_groups;

constexpr int NB = 16, SEQ = 2048, NMETA = 16, T = 2064, D = 2048, FF = 5632, M = NB * T;
constexpr int MINP = 6400, AINP = 4352, TP = 2112;
constexpr float EPS = 1e-6f;
constexpr int LDS_BYTES = 147456;
constexpr int NTHREADS = 512;

constexpr size_t SZ_GU = (size_t)2 * FF * D * 2, SZ_DN = (size_t)D * FF * 2;
constexpr size_t WS_GU = 0, WS_DN = 4 * SZ_GU, WS_MIN = WS_DN + 4 * SZ_DN, WS_MOUT = WS_MIN + (size_t)MINP * D * 2,
                 WS_AIN = WS_MOUT + (size_t)D * D * 2, WS_AOUT = WS_AIN + (size_t)AINP * D * 2, WS_HB = WS_AOUT + (size_t)D * D * 2,
                 WS_P = WS_HB + (size_t)M * D * 2, WS_HMETA = WS_P + (size_t)M * MINP * 2, WS_SSQ = WS_HMETA + (size_t)NB * NMETA * D * 4,
                 WS_MASK = WS_SSQ + 6 * (size_t)M * 128, WS_VT = WS_MASK + (size_t)M * 66 * 4, WS_PART = WS_VT + (size_t)NB * 4 * 128 * TP * 2, WS_BAR = WS_PART + (size_t)8 * 22 * 256 * 256 * 4, WS_KIC = WS_BAR + 16384, WS_RSTD = WS_KIC + (size_t)M * 64 * 2, WS_END = WS_RSTD + 6 * (size_t)M * 4;

namespace pg8 {
#define PG8_LAS __attribute__((address_space(3)))
typedef unsigned short bf16_t;
typedef short bf16x8 __attribute__((ext_vector_type(8)));
typedef float f32x4 __attribute__((ext_vector_type(4)));
typedef unsigned u32x4 __attribute__((ext_vector_type(4)));
typedef unsigned u32x2 __attribute__((ext_vector_type(2)));
constexpr int BM = 256, BK = 64, HALF = 128, HTB = HALF * BK * 2  , STAGE_BYTES = 8 * HTB, NXCD = 8, WGM = 4;

__host__ __device__ __forceinline__ int lds_byte(int r, int c) { const int st = (r >> 4) * 2 + (c >> 5), rr = r & 15, cc = c & 31, ob = rr * 64 + cc * 2; return st * 1024 + (ob ^ (((ob >> 9) & 1) << 5)); }
__host__ __device__ __forceinline__ void stage_rc(int b, int& R, int& C) { const int st = b / 1024, sb = b % 1024, swz = sb ^ (((sb >> 9) & 1) << 5); R = (st >> 1) * 16 + swz / 64; C = (st & 1) * 32 + (swz % 64) / 2; }
__host__ __device__ __forceinline__ int perm32(int rho) { const int n = rho >> 4, i = rho & 15; return 8 * (i >> 2) + 4 * n + (i & 3); }

struct Unit { int pm, pn, kt0, nkt, slice; };
struct Gemm { const bf16_t* A; const bf16_t* Bt; int M, N, K, lda; };

struct StaticOrder {
    int nM, nN, nwg, G, c, ntK;
    __host__ __device__ void init(int M, int N, int K, int G_, int c_) { nM = M / BM; nN = N / BM; nwg = nM * nN; G = G_; c = c_; ntK = K / BK; }
    __host__ __device__ __forceinline__ Unit next(int i) const {
        Unit u; u.pm = -1; u.pn = 0; u.kt0 = 0; u.nkt = ntK; u.slice = -1;
        const long L = (long)i * G + c; if (L >= nwg) return u;
        int wgid = (int)L; { const int q = nwg / NXCD, r = nwg % NXCD, xcd = wgid % NXCD, off = wgid / NXCD; wgid = (xcd < r ? xcd * (q + 1) : r * (q + 1) + (xcd - r) * q) + off; }
        const int nig = WGM * nN, gid = wgid / nig, fm = gid * WGM, gsz = (nM - fm) < WGM ? (nM - fm) : WGM;
        u.pm = fm + ((wgid % nig) % gsz); u.pn = (wgid % nig) / gsz; return u;
    }
    __device__ __forceinline__ void a_ready(const Unit&) const {}
    __device__ __forceinline__ void done(const Unit&) const {}
};
struct TailOrder {
    StaticOrder S; int NS, kts, pmLast;
    __host__ __device__ void init(int M, int N, int K, int NS_, int G_, int c_) { S.init(M - BM, N, K, G_, c_); NS = NS_; kts = (K / BK) / NS_; pmLast = M / BM - 1; }
    __host__ __device__ __forceinline__ Unit next(int i) const {
        const long L = (long)i * S.G + S.c;
        if (L < S.nwg) return S.next(i);
        Unit u; u.pm = -1; u.pn = 0; u.kt0 = 0; u.nkt = kts; u.slice = -1;
        const int item = (int)(L - S.nwg); if (item >= S.nN * NS) return u;
        u.pm = pmLast; u.pn = item / NS; u.slice = item - u.pn * NS; u.kt0 = u.slice * kts; return u;
    }
    __device__ __forceinline__ void a_ready(const Unit&) const {}
    __device__ __forceinline__ void done(const Unit&) const {}
};
typedef __bf16 bf16n2 __attribute__((ext_vector_type(2)));
typedef float f32x2n __attribute__((ext_vector_type(2)));
__device__ __forceinline__ unsigned cvt_pk_bf16(float lo, float hi) { const f32x2n v = {lo, hi}; return __builtin_bit_cast(unsigned, __builtin_convertvector(v, bf16n2)); }

__device__ __forceinline__ float row_rstd(const float* rstd, int row) { return rstd[row]; }
struct EpiSwiglu {
    static constexpr bool PERM = true, AFTER_DRAIN = false;
    bf16_t* O; const float* ssq;
    __device__ __forceinline__ void operator()(const f32x4 (&acc)[2][2][4][2], const Unit& u, int wr, int wc, int fr, int fq) const {
        const int row0 = u.pm * BM + wr * 64 + fr, col = u.pn * HALF + wc * 32 + 8 * fq;
#pragma unroll
        for (int ai = 0; ai < 2; ++ai)
#pragma unroll
            for (int m = 0; m < 4; ++m) {
                const int row = row0 + ai * HALF + m * 16; const float rs = row_rstd(ssq, row);
                float o[8];
#pragma unroll
                for (int n = 0; n < 2; ++n)
#pragma unroll
                    for (int j = 0; j < 4; ++j) { const float g = acc[ai][0][m][n][j] * rs, uu = acc[ai][1][m][n][j] * rs;
                        o[n * 4 + j] = g * __builtin_amdgcn_rcpf(1.0f + __builtin_amdgcn_exp2f(-1.4426950408889634f * g)) * uu; }
                u32x4 w; w.x = cvt_pk_bf16(o[0], o[1]); w.y = cvt_pk_bf16(o[2], o[3]); w.z = cvt_pk_bf16(o[4], o[5]); w.w = cvt_pk_bf16(o[6], o[7]);
                *(u32x4*)(O + (size_t)row * FF + col) = w;
            }
    }
};
struct EpiRowScale {
    static constexpr bool PERM = true, AFTER_DRAIN = false;
    bf16_t* O; int ldc; const float* ssq;
    __device__ __forceinline__ void operator()(const f32x4 (&acc)[2][2][4][2], const Unit& u, int wr, int wc, int fr, int fq) const {
        const int row0 = u.pm * BM + wr * 64 + fr, col0 = u.pn * BM + wc * 32 + 8 * fq;
#pragma unroll
        for (int ai = 0; ai < 2; ++ai)
#pragma unroll
            for (int m = 0; m < 4; ++m) {
                const int row = row0 + ai * HALF + m * 16; const float rs = row_rstd(ssq, row);
#pragma unroll
                for (int bj = 0; bj < 2; ++bj) { const f32x4 v0 = acc[ai][bj][m][0] * rs, v1 = acc[ai][bj][m][1] * rs;
                    u32x4 w; w.x = cvt_pk_bf16(v0[0], v0[1]); w.y = cvt_pk_bf16(v0[2], v0[3]); w.z = cvt_pk_bf16(v1[0], v1[1]); w.w = cvt_pk_bf16(v1[2], v1[3]);
                    *(u32x4*)(O + (size_t)row * ldc + col0 + bj * HALF) = w; }
            }
    }
};
struct EpiResid {
    static constexpr bool PERM = true, AFTER_DRAIN = false;
    bf16_t* hb; float* ssq_next; float* fout; float scale; float* part; int NS;
    __device__ __forceinline__ void operator()(const f32x4 (&acc)[2][2][4][2], const Unit& u, int wr, int wc, int fr, int fq) const {
        if (u.slice >= 0) {
            float* pp = part + ((size_t)(u.pn * NS + u.slice) * BM + wr * 64 + fr) * BM + wc * 32 + 8 * fq;
#pragma unroll
            for (int ai = 0; ai < 2; ++ai)
#pragma unroll
                for (int m = 0; m < 4; ++m)
#pragma unroll
                    for (int bj = 0; bj < 2; ++bj) { float* q = pp + (size_t)(ai * HALF + m * 16) * BM + bj * HALF; *(f32x4*)q = acc[ai][bj][m][0]; *(f32x4*)(q + 4) = acc[ai][bj][m][1]; }
            return;
        }
        const int row0 = u.pm * BM + wr * 64 + fr, col0 = u.pn * BM + wc * 32 + 8 * fq;
#pragma unroll
        for (int ai = 0; ai < 2; ++ai) {
            u32x4 hv[4][2];
#pragma unroll
            for (int m = 0; m < 4; ++m)
#pragma unroll
                for (int bj = 0; bj < 2; ++bj) hv[m][bj] = *(const u32x4*)(hb + (size_t)(row0 + ai * HALF + m * 16) * D + col0 + bj * HALF);
#pragma unroll
            for (int m = 0; m < 4; ++m) {
                const int row = row0 + ai * HALF + m * 16; float ss = 0.f;
                const int b = row / T, t = row - b * T; float* op = fout + ((size_t)b * SEQ + (t - NMETA)) * D + col0;
#pragma unroll
                for (int bj = 0; bj < 2; ++bj) { const u32x4 v = hv[m][bj];
                    f32x4 h0 = {__builtin_bit_cast(float, v.x << 16), __builtin_bit_cast(float, v.x & 0xffff0000u), __builtin_bit_cast(float, v.y << 16), __builtin_bit_cast(float, v.y & 0xffff0000u)};
                    f32x4 h1 = {__builtin_bit_cast(float, v.z << 16), __builtin_bit_cast(float, v.z & 0xffff0000u), __builtin_bit_cast(float, v.w << 16), __builtin_bit_cast(float, v.w & 0xffff0000u)};
                    h0 += acc[ai][bj][m][0] * scale; h1 += acc[ai][bj][m][1] * scale;
                    if (fout) { if (t >= NMETA) { *(f32x4*)(op + bj * HALF) = h0; *(f32x4*)(op + bj * HALF + 4) = h1; } }
                    else { u32x4 w; w.x = cvt_pk_bf16(h0[0], h0[1]); w.y = cvt_pk_bf16(h0[2], h0[3]); w.z = cvt_pk_bf16(h1[0], h1[1]); w.w = cvt_pk_bf16(h1[2], h1[3]);
                        *(u32x4*)(hb + (size_t)row * D + col0 + bj * HALF) = w;
                        ss += (h0[0] * h0[0] + h0[1] * h0[1]) + (h0[2] * h0[2] + h0[3] * h0[3]) + (h1[0] * h1[0] + h1[1] * h1[1]) + (h1[2] * h1[2] + h1[3] * h1[3]); }
                }
                if (!fout) { ss += __shfl_xor(ss, 16); ss += __shfl_xor(ss, 32); if (fq == 0) ssq_next[(size_t)row * 32 + u.pn * 4 + wc] = ss; }
            }
        }
    }
};
template <class Epi, class Sched, bool ALIGN_EPI = false, bool SP2 = false>
__device__ __forceinline__ void gemm_phase(PG8_LAS unsigned char* lds, const Gemm g, const Sched& S, const Epi& E) {
    const int tid = threadIdx.x, wid = __builtin_amdgcn_readfirstlane(tid >> 6), lane = tid & 63, wr = wid >> 2, wc = wid & 3, fr = lane & 15, fq = lane >> 4;
    const int K = g.K;
    unsigned voffA[2], voffB[2];
#pragma unroll
    for (int i = 0; i < 2; ++i) { int R, C; stage_rc(tid * 16 + i * 8192, R, C); const int Rb = Epi::PERM ? ((R & ~31) + perm32(R & 31)) : R;
        voffA[i] = (unsigned)(R * g.lda + C) * 2u; voffB[i] = (unsigned)(Rb * K + C) * 2u; }
    const size_t kstep = (size_t)(BK * 2);
    const size_t hstepA = (size_t)HALF * g.lda * 2, hstepB = (size_t)HALF * K * 2;
    const size_t tstepA = 2 * hstepA, tstepB = 2 * hstepB;
    const unsigned ldsw = (unsigned)wid * 1024u;
    const int aoff = lds_byte(wr * 64 + fr, fq * 8), boff = lds_byte(wc * 32 + fr, fq * 8);
#define PG8_SA(b, h) (((b) * 2 + (h)) * HTB)
#define PG8_SB(b, h) ((4 + (b) * 2 + (h)) * HTB)
#define PG8_STAGE(bufoff, gbase, voff) do { _Pragma("unroll") for (int _i = 0; _i < 2; ++_i) \
        __builtin_amdgcn_global_load_lds((const unsigned*)((const char*)(gbase) + (voff)[_i]), (PG8_LAS unsigned*)(lds + (bufoff) + ldsw + _i * 8192), 16, 0, 0); } while (0)
#define PG8_LDA(dst, b, h) do { _Pragma("unroll") for (int m = 0; m < 4; ++m) _Pragma("unroll") for (int k = 0; k < 2; ++k) dst[m][k] = *(const PG8_LAS bf16x8*)(lds + PG8_SA(b, h) + aoff + m * 2048 + k * 1024); } while (0)
#define PG8_LDB(dst, b, h) do { _Pragma("unroll") for (int n = 0; n < 2; ++n) _Pragma("unroll") for (int k = 0; k < 2; ++k) dst[n][k] = *(const PG8_LAS bf16x8*)(lds + PG8_SB(b, h) + boff + n * 2048 + k * 1024); } while (0)
#define PG8_MMA(ai, bj, At, Bt) do { __builtin_amdgcn_s_setprio(1); _Pragma("unroll") for (int m = 0; m < 4; ++m) _Pragma("unroll") for (int n = 0; n < 2; ++n) _Pragma("unroll") for (int k = 0; k < 2; ++k) \
        acc[ai][bj][m][n] = __builtin_amdgcn_mfma_f32_16x16x32_bf16(Bt[n][k], At[m][k], acc[ai][bj][m][n], 0, 0, 0); __builtin_amdgcn_s_setprio(0); } while (0)
#define PG8_WAIT_V(n) asm volatile("s_waitcnt vmcnt(" #n ")" ::: "memory")
#define PG8_WAIT_L(n) asm volatile("s_waitcnt lgkmcnt(" #n ")" ::: "memory")
#define PG8_BAR __builtin_amdgcn_s_barrier()
#define PG8_SCHED __builtin_amdgcn_sched_barrier(0)
    Unit cur, nxt; int ui = 0;
    cur = S.next(0); if (cur.pm < 0) return;
    f32x4 acc[2][2][4][2];
#pragma unroll
    for (int a = 0; a < 2; ++a)
#pragma unroll
        for (int b = 0; b < 2; ++b)
#pragma unroll
            for (int m = 0; m < 4; ++m)
#pragma unroll
                for (int n = 0; n < 2; ++n) acc[a][b][m][n] = (f32x4){0.f, 0.f, 0.f, 0.f};
    bf16x8 At[4][2], B0[2][2], B1[2][2];
    const char* cA = (const char*)g.A + (size_t)cur.pm * tstepA + (size_t)cur.kt0 * (BK * 2); const char* cB = (const char*)g.Bt + (size_t)cur.pn * tstepB + (size_t)cur.kt0 * (BK * 2);
    S.a_ready(cur);
    if constexpr (SP2) {
        PG8_STAGE(PG8_SB(0, 0), cB, voffB); PG8_STAGE(PG8_SB(0, 1), cB + hstepB, voffB); PG8_STAGE(PG8_SA(0, 0), cA, voffA); PG8_STAGE(PG8_SA(0, 1), cA + hstepA, voffA);
        if (wr == 1) PG8_BAR;
        PG8_WAIT_V(2); PG8_BAR;
        PG8_STAGE(PG8_SB(1, 0), cB + kstep, voffB); PG8_STAGE(PG8_SA(1, 0), cA + kstep, voffA); PG8_STAGE(PG8_SB(1, 1), cB + hstepB + kstep, voffB);
        PG8_WAIT_V(6); PG8_BAR;
    } else {
        PG8_STAGE(PG8_SB(0, 0), cB, voffB); PG8_STAGE(PG8_SA(0, 0), cA, voffA); PG8_STAGE(PG8_SB(0, 1), cB + hstepB, voffB); PG8_STAGE(PG8_SA(0, 1), cA + hstepA, voffA);
        if (wr == 1) PG8_BAR;
        PG8_WAIT_V(4); PG8_BAR;
        PG8_STAGE(PG8_SB(1, 0), cB + kstep, voffB); PG8_STAGE(PG8_SA(1, 0), cA + kstep, voffA); PG8_STAGE(PG8_SB(1, 1), cB + hstepB + kstep, voffB);
        PG8_WAIT_V(6); PG8_BAR;
    }
    for (;;) {
        nxt = S.next(ui + 1); const bool has_next = nxt.pm >= 0;
        const char* nA = has_next ? (const char*)g.A + (size_t)nxt.pm * tstepA + (size_t)nxt.kt0 * (BK * 2) : cA; const char* nB = has_next ? (const char*)g.Bt + (size_t)nxt.pn * tstepB + (size_t)nxt.kt0 * (BK * 2) : cB;
        const int nt = cur.nkt;
        for (int t = 0; t < nt; t += 2) {
            const bool last = (t == nt - 2);
            const char* a1 = cA + (size_t)(t + 1) * kstep;
            const char* a2 = last ? nA : cA + (size_t)(t + 2) * kstep; const char* b2 = last ? nB : cB + (size_t)(t + 2) * kstep;
            const char* a3 = a2 + kstep; const char* b3 = b2 + kstep;
            if (last && has_next) S.a_ready(nxt);
            if constexpr (SP2) {
            PG8_LDB(B0, 0, 0); PG8_LDB(B1, 0, 1); PG8_SCHED; PG8_LDA(At, 0, 0); PG8_STAGE(PG8_SA(1, 1), a1 + hstepA, voffA);
            PG8_WAIT_V(8); PG8_WAIT_L(0); PG8_BAR; PG8_MMA(0, 0, At, B0); PG8_MMA(0, 1, At, B1); PG8_BAR; PG8_SCHED;
            PG8_LDA(At, 0, 1); PG8_STAGE(PG8_SB(0, 0), b2, voffB); PG8_STAGE(PG8_SB(0, 1), b2 + hstepB, voffB); PG8_STAGE(PG8_SA(0, 0), a2, voffA);
            PG8_WAIT_V(8); PG8_WAIT_L(0); PG8_BAR; PG8_MMA(1, 0, At, B0); PG8_MMA(1, 1, At, B1); PG8_BAR; PG8_SCHED;
            PG8_LDB(B0, 1, 0); PG8_LDB(B1, 1, 1); PG8_SCHED; PG8_LDA(At, 1, 0); PG8_STAGE(PG8_SA(0, 1), a2 + hstepA, voffA);
            PG8_WAIT_V(8); PG8_WAIT_L(0); PG8_BAR; PG8_MMA(0, 0, At, B0); PG8_MMA(0, 1, At, B1); PG8_BAR; PG8_SCHED;
            PG8_LDA(At, 1, 1); PG8_STAGE(PG8_SB(1, 0), b3, voffB); PG8_STAGE(PG8_SB(1, 1), b3 + hstepB, voffB); PG8_STAGE(PG8_SA(1, 0), a3, voffA);
            PG8_WAIT_V(8); PG8_WAIT_L(0); PG8_BAR; PG8_MMA(1, 0, At, B0); PG8_MMA(1, 1, At, B1); PG8_BAR; PG8_SCHED;
            } else {
            PG8_LDB(B0, 0, 0); PG8_SCHED; PG8_LDA(At, 0, 0); PG8_STAGE(PG8_SA(1, 1), a1 + hstepA, voffA);
            PG8_WAIT_L(8); PG8_BAR; PG8_WAIT_L(0); PG8_MMA(0, 0, At, B0); PG8_BAR; PG8_SCHED;
            PG8_LDB(B1, 0, 1); PG8_STAGE(PG8_SB(0, 0), b2, voffB);
            PG8_BAR; PG8_WAIT_L(0); PG8_MMA(0, 1, At, B1); PG8_BAR;
            PG8_LDA(At, 0, 1); PG8_STAGE(PG8_SA(0, 0), a2, voffA);
            PG8_BAR; PG8_WAIT_L(0); PG8_MMA(1, 0, At, B0); PG8_BAR; PG8_SCHED;
            PG8_STAGE(PG8_SB(0, 1), b2 + hstepB, voffB);
            PG8_WAIT_V(6); PG8_BAR; PG8_MMA(1, 1, At, B1); PG8_BAR;
            PG8_LDB(B0, 1, 0); PG8_SCHED; PG8_LDA(At, 1, 0); PG8_STAGE(PG8_SA(0, 1), a2 + hstepA, voffA);
            PG8_WAIT_L(8); PG8_BAR; PG8_WAIT_L(0); PG8_MMA(0, 0, At, B0); PG8_BAR; PG8_SCHED;
            PG8_LDB(B1, 1, 1); PG8_STAGE(PG8_SB(1, 0), b3, voffB);
            PG8_BAR; PG8_WAIT_L(0); PG8_MMA(0, 1, At, B1); PG8_BAR;
            PG8_LDA(At, 1, 1); PG8_STAGE(PG8_SA(1, 0), a3, voffA);
            PG8_BAR; PG8_WAIT_L(0); PG8_MMA(1, 0, At, B0); PG8_BAR; PG8_SCHED;
            PG8_STAGE(PG8_SB(1, 1), b3 + hstepB, voffB);
            PG8_WAIT_V(6); PG8_BAR; PG8_MMA(1, 1, At, B1); PG8_BAR;
            }
        }
        if constexpr (ALIGN_EPI) { if (wr == 0) PG8_BAR; }
        if constexpr (!Epi::AFTER_DRAIN) { E(acc, cur, wr, wc, fr, fq); S.done(cur); }
        if (!has_next) break;
#pragma unroll
        for (int a = 0; a < 2; ++a)
#pragma unroll
            for (int b = 0; b < 2; ++b)
#pragma unroll
                for (int m = 0; m < 4; ++m)
#pragma unroll
                    for (int n = 0; n < 2; ++n) acc[a][b][m][n] = (f32x4){0.f, 0.f, 0.f, 0.f};
        cur = nxt; cA = nA; cB = nB; ++ui;
        if constexpr (ALIGN_EPI) { if (wr == 1) PG8_BAR; }
    }
    PG8_WAIT_V(0);
    if constexpr (!ALIGN_EPI) { if (wr == 0) PG8_BAR; }
    PG8_BAR;
    if constexpr (Epi::AFTER_DRAIN) { E.fused(acc, cur, wr, wc, fr, fq, lds, wid, lane); S.done(cur); }
#undef PG8_SA
#undef PG8_SB
#undef PG8_STAGE
#undef PG8_LDA
#undef PG8_LDB
#undef PG8_MMA
#undef PG8_WAIT_V
#undef PG8_WAIT_L
#undef PG8_BAR
#undef PG8_SCHED
}
}
using pg8::bf16_t; using pg8::bf16x8; using pg8::f32x4; using pg8::u32x4; using pg8::u32x2; using pg8::cvt_pk_bf16;
#define LAS __attribute__((address_space(3)))
typedef short bf16x4 __attribute__((ext_vector_type(4)));
#define LDS_WAIT() asm volatile("s_waitcnt lgkmcnt(0)" ::: "memory")
__device__ __forceinline__ float bf2f(unsigned h) { return __builtin_bit_cast(float, h << 16); }
__device__ __forceinline__ float bflo(unsigned w) { return __builtin_bit_cast(float, w << 16); }
__device__ __forceinline__ float bfhi(unsigned w) { return __builtin_bit_cast(float, w & 0xffff0000u); }
__device__ __forceinline__ unsigned short f2bf1(float f) { return (unsigned short)(cvt_pk_bf16(f, 0.f) & 0xffffu); }
__device__ __forceinline__ float wave_sum(float v) {
#pragma unroll
    for (int o = 1; o < 64; o <<= 1) v += __shfl_xor(v, o);
    return v;
}
__device__ __forceinline__ f32x4 mfma16(bf16x8 a, bf16x8 b, f32x4 c) { return __builtin_amdgcn_mfma_f32_16x16x32_bf16(a, b, c, 0, 0, 0); }
__device__ __forceinline__ bf16x8 cat8(u32x2 lo, u32x2 hi) { u32x4 w; w.x = lo.x; w.y = lo.y; w.z = hi.x; w.w = hi.y; return __builtin_bit_cast(bf16x8, w); }

#define XB_TMO      128
#define XB_XCNT(j)  (256  + 64 * (j))
#define XB_XSUB(j)  (1280 + 64 * (j))
#define XB_XGEN(j)  (2304 + 64 * (j))
#define XB_TOP      3328
#define XB_TOPGEN   3392
#define XCD_BAR_WORDS 3456
#define XB_SPIN_CAP (1u << 18)

__device__ __forceinline__ unsigned xb_ld(unsigned* p)              { return __hip_atomic_load(p, __ATOMIC_RELAXED, __HIP_MEMORY_SCOPE_AGENT); }
__device__ __forceinline__ unsigned xb_add(unsigned* p, unsigned v) { return __hip_atomic_fetch_add(p, v, __ATOMIC_RELAXED, __HIP_MEMORY_SCOPE_AGENT); }
__device__ __forceinline__ unsigned xb_xcc_id() { return (unsigned)__builtin_amdgcn_s_getreg((3 << 11) | 20) & 0xFu; }
#define XB_SPIN(cond, bar) do { unsigned _sp = 0; while (cond) { __builtin_amdgcn_s_sleep(1); \
    if ((++_sp & 255u) == 0u) { if (xb_ld(&(bar)[XB_TMO])) break; if (_sp > XB_SPIN_CAP) { atomicAdd(&(bar)[XB_TMO], 1u); break; } } } } while (0)

struct XcdBarrier {
    unsigned* bar; unsigned x;
    volatile LAS unsigned* st;
};

__device__ __forceinline__ XcdBarrier xcd_barrier_post(unsigned* bar, volatile LAS unsigned* st) {
    XcdBarrier b; b.bar = bar; b.x = xb_xcc_id(); b.st = st;
    if (threadIdx.x == 0) (void)xb_add(&bar[XB_XCNT(b.x)], 1u);
    return b;
}
__device__ __forceinline__ void xcd_barrier_complete(unsigned* bar, unsigned x, unsigned& nloc, unsigned& nx) {
    const unsigned G = gridDim.x * gridDim.y * gridDim.z;
    unsigned sum, cnt, mine, sp = 0u;
    for (;;) {
        sum = 0u; cnt = 0u; mine = 0u;
#pragma unroll
        for (unsigned j = 0; j < 16; ++j) { const unsigned c = xb_ld(&bar[XB_XCNT(j)]); sum += c; cnt += (c > 0u) ? 1u : 0u; mine = (j == x) ? c : mine; }
        if (sum == G) break;
        __builtin_amdgcn_s_sleep(1);
        if ((++sp & 255u) == 0u) { if (xb_ld(&bar[XB_TMO])) break; if (sp > XB_SPIN_CAP) { atomicAdd(&bar[XB_TMO], 1u); break; } }
    }
    nloc = mine > 0u ? mine : 1u; nx = cnt > 0u ? cnt : 1u;
}

__device__ __forceinline__ void xcd_barrier(const XcdBarrier& b) {
    asm volatile("s_waitcnt vmcnt(0)" ::: "memory");
    __syncthreads();
    if (threadIdx.x == 0) {
        unsigned* bar = b.bar;
        __builtin_amdgcn_s_waitcnt(0);
        unsigned nloc = b.st[0], nx = b.st[1];
        if (nloc == 0u) { xcd_barrier_complete(bar, b.x, nloc, nx); b.st[0] = nloc; b.st[1] = nx; }
        const unsigned old = xb_add(&bar[XB_XSUB(b.x)], 1u);
        const unsigned gen = old / nloc;
        if (old + 1u == (gen + 1u) * nloc) {
            __builtin_amdgcn_fence(__ATOMIC_RELEASE, "agent");
            asm volatile("s_waitcnt vmcnt(0)" ::: "memory");
            const unsigned og = xb_add(&bar[XB_TOP], 1u);
            const unsigned tg = og / nx;
            if (og + 1u == (tg + 1u) * nx) xb_add(&bar[XB_TOPGEN], 1u);
            else XB_SPIN(xb_ld(&bar[XB_TOPGEN]) == tg, bar);
            __builtin_amdgcn_fence(__ATOMIC_ACQUIRE, "agent");
            xb_add(&bar[XB_XGEN(b.x)], 1u);
            asm volatile("s_waitcnt vmcnt(0)" ::: "memory");
        } else {
            XB_SPIN(xb_ld(&bar[XB_XGEN(b.x)]) == gen, bar);
            __builtin_amdgcn_fence(__ATOMIC_ACQUIRE, "agent");
            asm volatile("s_waitcnt vmcnt(0)" ::: "memory");
        }
    }
    __syncthreads();
}

struct Args { const float* in[20]; float* out; unsigned char* ws; int ph_lo, ph_hi; };

__device__ __forceinline__ void transpose_item(const float* W, int K, int N, bf16_t* WT, int dst_row0, const float* gain, int qcols, LAS float* scr, int kb, int nb, int lane) {
    const int k0 = 64 * kb, n0 = 64 * nb, n4 = lane & 15, kr = lane >> 4, n = n0 + 4 * n4; const bool nin = n < N; const float cs = (n < qcols) ? 0.0625f : 1.0f;
    f32x4 v[16];
#pragma unroll
    for (int i = 0; i < 16; ++i) { v[i] = (f32x4){0.f, 0.f, 0.f, 0.f}; if (nin) v[i] = *(const f32x4*)(W + (size_t)(k0 + 4 * i + kr) * N + n); }
#pragma unroll
    for (int i = 0; i < 16; ++i) { const int kk = 4 * i + kr; const float gk = (gain ? gain[k0 + kk] : 1.0f) * cs; LAS float* d = scr + kk * 65 + 4 * n4;
        d[0] = v[i][0] * gk; d[1] = v[i][1] * gk; d[2] = v[i][2] * gk; d[3] = v[i][3] * gk; }
    LDS_WAIT();
    const int c = lane & 7;
#pragma unroll
    for (int j = 0; j < 8; ++j) { const int nn = (lane >> 3) + 8 * j; const LAS float* s = scr + (8 * c) * 65 + nn;
        u32x4 o; o.x = cvt_pk_bf16(s[0 * 65], s[1 * 65]); o.y = cvt_pk_bf16(s[2 * 65], s[3 * 65]); o.z = cvt_pk_bf16(s[4 * 65], s[5 * 65]); o.w = cvt_pk_bf16(s[6 * 65], s[7 * 65]);
        *(u32x4*)(WT + (size_t)(dst_row0 + nn) * K + k0 + 8 * c) = o; }
    LDS_WAIT();
}
__device__ __forceinline__ void prologue_phase(LAS unsigned char* lds, const Args& a) {
    const int tid = threadIdx.x, lane = tid & 63, wid = tid >> 6;
    const int gw = blockIdx.x * 8 + wid, NGW = gridDim.x * 8;
    LAS float* scr = (LAS float*)(lds + wid * 16640);
    unsigned char* ws = a.ws;
    constexpr int I_G = (D / 64) * (FF / 64), I_D = (FF / 64) * (D / 64), I_MI = (D / 64) * (MINP / 64), I_O = (D / 64) * (D / 64), I_AI = (D / 64) * (AINP / 64);
    constexpr int NITEMS = 12 * I_G + I_MI + 2 * I_O + I_AI;
    static_assert(I_G == I_D, "items");
    for (int it = gw; it < NITEMS; it += NGW) {
        int r = it;
        if (r < 12 * I_G) {
            const int f = r / (3 * I_G); r -= f * 3 * I_G; const int which = r / I_G; r -= which * I_G;
            const int layer = f >> 1, second = f & 1;
            if (which < 2) {
                const float* W = a.in[(second ? 8 : 3) + which] + (size_t)layer * D * FF; const float* gain = a.in[second ? 7 : 2] + layer * D;
                const int nblk = FF / 64, kb = r / nblk, nb = r % nblk, n0 = 64 * nb;
                const int dst_row0 = (n0 >> 7) * 256 + which * 128 + (n0 & 127);
                transpose_item(W, D, FF, (bf16_t*)(ws + WS_GU + f * SZ_GU), dst_row0, gain, 0, scr, kb, nb, lane);
            } else {
                const float* W = a.in[second ? 10 : 5] + (size_t)layer * FF * D;
                const int nblk = D / 64, kb = r / nblk, nb = r % nblk;
                transpose_item(W, FF, D, (bf16_t*)(ws + WS_DN + f * SZ_DN), 64 * nb, nullptr, 0, scr, kb, nb, lane);
            }
            continue;
        }
        r -= 12 * I_G;
        if (r < I_MI) { const int nblk = MINP / 64, kb = r / nblk, nb = r % nblk; transpose_item(a.in[11], D, 6152, (bf16_t*)(ws + WS_MIN), 64 * nb, a.in[6], 1024, scr, kb, nb, lane); continue; }
        r -= I_MI;
        if (r < I_O) { const int nblk = D / 64, kb = r / nblk, nb = r % nblk; transpose_item(a.in[15], D, D, (bf16_t*)(ws + WS_MOUT), 64 * nb, nullptr, 0, scr, kb, nb, lane); continue; }
        r -= I_O;
        if (r < I_AI) { const int nblk = AINP / 64, kb = r / nblk, nb = r % nblk; transpose_item(a.in[16], D, 4176, (bf16_t*)(ws + WS_AIN), 64 * nb, a.in[6] + D, 0, scr, kb, nb, lane); continue; }
        r -= I_AI;
        { const int nblk = D / 64, kb = r / nblk, nb = r % nblk; transpose_item(a.in[19], D, D, (bf16_t*)(ws + WS_AOUT), 64 * nb, nullptr, 0, scr, kb, nb, lane); }
    }
    bf16_t* hb = (bf16_t*)(ws + WS_HB); float* rstd0 = (float*)(ws + WS_RSTD);
    for (int r = gw; r < M; r += NGW) {
        const int b = r / T, t = r - b * T;
        const float* src = t < NMETA ? a.in[1] + (size_t)t * D : a.in[0] + ((size_t)b * SEQ + (t - NMETA)) * D;
        float ss = 0.f;
#pragma unroll
        for (int j = 0; j < 8; ++j) { const f32x4 v = ((const f32x4*)src)[lane + 64 * j];
            u32x2 w; w.x = cvt_pk_bf16(v[0], v[1]); w.y = cvt_pk_bf16(v[2], v[3]); *(u32x2*)(hb + (size_t)r * D + 4 * (lane + 64 * j)) = w;
            ss += (v[0] * v[0] + v[1] * v[1]) + (v[2] * v[2] + v[3] * v[3]); }
        ss = wave_sum(ss); if (lane == 0) rstd0[r] = __builtin_amdgcn_rsqf(ss * (1.0f / D) + EPS);
    }
}

constexpr int ML_Q = 0, ML_K = 33792, ML_KT = 67584, ML_VT = 104448, ML_SP = 122880, ML_FL = 132096;
__device__ __forceinline__ float logsigmoid(float x) { return fminf(x, 0.f) - log1pf(__expf(-fabsf(x))); }
__device__ __forceinline__ void mlstm_scan_phase(LAS unsigned char* lds, const bf16_t* P, bf16_t* Hout, int ldh, const float* b_i, const float* b_f) {
    const int tid = threadIdx.x, wid = __builtin_amdgcn_readfirstlane(tid >> 6), lane = tid & 63, fr = lane & 15, fq = lane >> 4;
    LAS float* fa = (LAS float*)(lds + ML_FL); LAS float* fMx = fa + 64; LAS float* fwk = fa + 128; LAS float* fwi = fa + 192; LAS float* fef = fa + 256;
    LAS float* frs = fa + 320; LAS float* fqn = fa + 384; LAS float* fn = fa + 448; LAS float* fmisc = fa + 704; LAS float* fsc = fa + 720; LAS float* frs4 = fa + 784;
    for (int unit = blockIdx.x; unit < 256; unit += gridDim.x) {
        const int bh = unit >> 2, sl = unit & 3, b = bh >> 2, h = bh & 3;
        f32x4 C[16];
#pragma unroll
        for (int i = 0; i < 16; ++i) C[i] = (f32x4){0.f, 0.f, 0.f, 0.f};
        if (tid < 256) fn[tid] = 0.f;
        float m_run = 0.f;
        const float bi = b_i[h], bfv = b_f[h];
        const size_t rowb = (size_t)b * T;
        unsigned short g_i = 0, g_f = 0;
        if (wid == 0) { const int tg = lane - 48; const bf16_t* pr = P + (rowb + (tg >= 0 ? tg : 0)) * MINP; g_i = pr[6144 + h]; g_f = pr[6148 + h]; }
        const int e0 = 16 * wid;
        __syncthreads();
        for (int c = 0; c < 33; ++c) {
            const int t0 = c * 64 - 48;
            if (wid == 0) {
                const int t = t0 + lane; const bool valid = t >= 0;
                const float ig = valid ? bf2f(g_i) + bi : -1e30f;
                const float lf = valid ? logsigmoid(bf2f(g_f) + bfv) : 0.f;
                { const int tn = t + 64; const bf16_t* pr = P + (rowb + (tn < T ? tn : T - 1)) * MINP; g_i = pr[6144 + h]; g_f = pr[6148 + h]; }
                float bc = lf;
#pragma unroll
                for (int o = 1; o < 64; o <<= 1) { const float v = __shfl_up(bc, o); if (lane >= o) bc += v; }
                const float av = ig - bc; float pm = av;
#pragma unroll
                for (int o = 1; o < 64; o <<= 1) { const float v = __shfl_up(pm, o); if (lane >= o) pm = fmaxf(pm, v); }
                const float Mx = fmaxf(m_run, pm), MxL = __shfl(Mx, 63), bL = __shfl(bc, 63);
                fa[lane] = av; fMx[lane] = Mx; fwk[lane] = __expf(av - MxL); fwi[lane] = __expf(m_run - Mx); fef[lane] = __expf(-(bc + Mx)); frs[lane] = 0.f;
                if (lane == 0) fmisc[1] = __expf(m_run - MxL);
                m_run = bL + MxL;
            }
            __syncthreads();
#pragma unroll
            for (int i = 0; i < 4; ++i) { const int ch = tid + 512 * i, l = ch >> 5, cc = ch & 31, t = t0 + l;
                u32x4 qv = {0u, 0u, 0u, 0u}, kv = {0u, 0u, 0u, 0u};
                if (t >= 0) { const bf16_t* pr = P + (rowb + t) * MINP + h * 256 + cc * 8; qv = *(const u32x4*)pr; kv = *(const u32x4*)(pr + 1024); }
                *(LAS u32x4*)(lds + ML_Q + l * 528 + cc * 16) = qv; *(LAS u32x4*)(lds + ML_K + l * 528 + cc * 16) = kv; }
#pragma unroll
            for (int i = 0; i < 4; ++i) { const int ch = tid + 512 * i, l = ch & 63, cc = ch >> 6, t = t0 + l;
                u32x4 kv = {0u, 0u, 0u, 0u};
                if (t >= 0) kv = *(const u32x4*)(P + (rowb + t) * MINP + 1024 + h * 256 + cc * 8);
                const float wk = fwk[l]; LAS bf16_t* dst = (LAS bf16_t*)(lds + ML_KT + (cc * 8) * 144 + l * 2);
                dst[0 * 72] = f2bf1(bflo(kv.x) * wk); dst[1 * 72] = f2bf1(bfhi(kv.x) * wk); dst[2 * 72] = f2bf1(bflo(kv.y) * wk); dst[3 * 72] = f2bf1(bfhi(kv.y) * wk);
                dst[4 * 72] = f2bf1(bflo(kv.z) * wk); dst[5 * 72] = f2bf1(bfhi(kv.z) * wk); dst[6 * 72] = f2bf1(bflo(kv.w) * wk); dst[7 * 72] = f2bf1(bfhi(kv.w) * wk); }
#pragma unroll
            for (int i = 0; i < 2; ++i) { const int ch = tid + 512 * i, l = ch & 63, cc = ch >> 6, t = t0 + l;
                u32x4 vv = {0u, 0u, 0u, 0u};
                if (t >= 0) vv = *(const u32x4*)(P + (rowb + t) * MINP + 2048 + h * 512 + sl * 128 + cc * 8);
                LAS bf16_t* dst = (LAS bf16_t*)(lds + ML_VT + (cc * 8) * 144 + l * 2);
                dst[0 * 72] = (bf16_t)(vv.x & 0xffffu); dst[1 * 72] = (bf16_t)(vv.x >> 16); dst[2 * 72] = (bf16_t)(vv.y & 0xffffu); dst[3 * 72] = (bf16_t)(vv.y >> 16);
                dst[4 * 72] = (bf16_t)(vv.z & 0xffffu); dst[5 * 72] = (bf16_t)(vv.z >> 16); dst[6 * 72] = (bf16_t)(vv.w & 0xffffu); dst[7 * 72] = (bf16_t)(vv.w >> 16); }
            __syncthreads();
            { const int l = tid >> 3, part = tid & 7; float s = 0.f;
#pragma unroll
              for (int i = 0; i < 4; ++i) { const u32x4 qv = *(const LAS u32x4*)(lds + ML_Q + l * 528 + (part * 32 + i * 8) * 2); const LAS float* np = fn + part * 32 + i * 8;
                  s += bflo(qv.x) * np[0] + bfhi(qv.x) * np[1] + bflo(qv.y) * np[2] + bfhi(qv.y) * np[3] + bflo(qv.z) * np[4] + bfhi(qv.z) * np[5] + bflo(qv.w) * np[6] + bfhi(qv.w) * np[7]; }
              s += __shfl_xor(s, 1); s += __shfl_xor(s, 2); s += __shfl_xor(s, 4); if (part == 0) fqn[l] = s; }
            { const int lt = wid >> 1;
#pragma unroll
              for (int s2 = 0; s2 < 2; ++s2) { const int st = (wid & 1) * 2 + s2;
                  if (st <= lt) {
                      f32x4 acc = {0.f, 0.f, 0.f, 0.f};
#pragma unroll
                      for (int ks = 0; ks < 8; ++ks) { const bf16x8 A = *(const LAS bf16x8*)(lds + ML_Q + (16 * lt + fr) * 528 + (32 * ks + fq * 8) * 2);
                          const bf16x8 Bv = *(const LAS bf16x8*)(lds + ML_K + (16 * st + fr) * 528 + (32 * ks + fq * 8) * 2); acc = mfma16(A, Bv, acc); }
                      const int s = 16 * st + fr; const float as = fa[s];
#pragma unroll
                      for (int j = 0; j < 4; ++j) { const int l = 16 * lt + fq * 4 + j; const float e = __expf(as - fMx[l]); float v = (s <= l) ? acc[j] * e : 0.f;
                          *(LAS bf16_t*)(lds + ML_SP + l * 144 + s * 2) = f2bf1(v);
                          v += __shfl_xor(v, 1); v += __shfl_xor(v, 2); v += __shfl_xor(v, 4); v += __shfl_xor(v, 8);
                          if (fr == 0) frs4[l * 4 + st] = v; }
                  } else {
#pragma unroll
                      for (int j = 0; j < 4; ++j) { *(LAS bf16_t*)(lds + ML_SP + (16 * lt + fq * 4 + j) * 144 + (16 * st + fr) * 2) = 0; if (fr == 0) frs4[(16 * lt + fq * 4 + j) * 4 + st] = 0.f; }
                  } } }
            __syncthreads();
            f32x4 o4[4];
#pragma unroll
            for (int lt = 0; lt < 4; ++lt) o4[lt] = (f32x4){0.f, 0.f, 0.f, 0.f};
#pragma unroll
            for (int ks = 0; ks < 8; ++ks) {
                if ((ks & 1) == 0) __builtin_amdgcn_sched_barrier(0);
                u32x4 bw; bw.x = cvt_pk_bf16(C[2 * ks][0], C[2 * ks][1]); bw.y = cvt_pk_bf16(C[2 * ks][2], C[2 * ks][3]); bw.z = cvt_pk_bf16(C[2 * ks + 1][0], C[2 * ks + 1][1]); bw.w = cvt_pk_bf16(C[2 * ks + 1][2], C[2 * ks + 1][3]);
                const bf16x8 Bf = __builtin_bit_cast(bf16x8, bw);
#pragma unroll
                for (int lt = 0; lt < 4; ++lt) { const LAS unsigned char* qp = lds + ML_Q + (16 * lt + fr) * 528 + (32 * ks + fq * 4) * 2;
                    const bf16x8 A = cat8(*(const LAS u32x2*)qp, *(const LAS u32x2*)(qp + 32)); o4[lt] = mfma16(A, Bf, o4[lt]); }
            }
#pragma unroll
            for (int lt = 0; lt < 4; ++lt)
#pragma unroll
                for (int j = 0; j < 4; ++j) o4[lt][j] *= fwi[16 * lt + fq * 4 + j];
            bf16x8 Bv[2];
#pragma unroll
            for (int ks = 0; ks < 2; ++ks) { Bv[ks] = *(const LAS bf16x8*)(lds + ML_VT + (e0 + fr) * 144 + (32 * ks + fq * 8) * 2);
#pragma unroll
                for (int lt = 0; lt < 4; ++lt) { const bf16x8 A = *(const LAS bf16x8*)(lds + ML_SP + (16 * lt + fr) * 144 + (32 * ks + fq * 8) * 2); o4[lt] = mfma16(A, Bv[ks], o4[lt]); } }
#pragma unroll
            for (int lt = 0; lt < 4; ++lt)
#pragma unroll
                for (int j = 0; j < 4; ++j) *(LAS float*)(lds + ML_K + (16 * lt + fq * 4 + j) * 528 + (e0 + fr) * 4) = o4[lt][j];
            __builtin_amdgcn_sched_barrier(0);
            const float decay = fmisc[1];
#pragma unroll
            for (int mt = 0; mt < 16; ++mt) { if ((mt & 3) == 0) __builtin_amdgcn_sched_barrier(0); C[mt] *= decay;
#pragma unroll
                for (int ks = 0; ks < 2; ++ks) { const bf16x8 A = *(const LAS bf16x8*)(lds + ML_KT + (16 * mt + fr) * 144 + (32 * ks + fq * 8) * 2); C[mt] = mfma16(A, Bv[ks], C[mt]); } }
            if (tid < 64) { const float den = fwi[tid] * fqn[tid] + ((frs4[tid * 4] + frs4[tid * 4 + 1]) + (frs4[tid * 4 + 2] + frs4[tid * 4 + 3])); fsc[tid] = 1.0f / fmaxf(fabsf(den), fef[tid]); }
            if (tid < 256) { float s = 0.f;
#pragma unroll
                for (int i = 0; i < 8; ++i) { const u32x4 kv = *(const LAS u32x4*)(lds + ML_KT + tid * 144 + i * 16);
                    s += (bflo(kv.x) + bfhi(kv.x)) + (bflo(kv.y) + bfhi(kv.y)) + (bflo(kv.z) + bfhi(kv.z)) + (bflo(kv.w) + bfhi(kv.w)); }
                fn[tid] = decay * fn[tid] + s; }
            __syncthreads();
#pragma unroll
            for (int i = 0; i < 2; ++i) { const int ch = tid + 512 * i, l = ch >> 4, cc = ch & 15, t = t0 + l;
                const float sc = fsc[l];
                const f32x4 v0 = *(const LAS f32x4*)(lds + ML_K + l * 528 + cc * 32), v1 = *(const LAS f32x4*)(lds + ML_K + l * 528 + cc * 32 + 16);
                u32x4 w; w.x = cvt_pk_bf16(v0[0] * sc, v0[1] * sc); w.y = cvt_pk_bf16(v0[2] * sc, v0[3] * sc); w.z = cvt_pk_bf16(v1[0] * sc, v1[1] * sc); w.w = cvt_pk_bf16(v1[2] * sc, v1[3] * sc);
                if (t >= 0) *(u32x4*)(Hout + (rowb + t) * ldh + h * 512 + sl * 128 + cc * 8) = w; }
        }
    }
}
template <int NS>
__device__ __forceinline__ void tail_fixup_phase(LAS unsigned char* lds, bf16_t* hb, const float* ssq_next, float* rstd_next, float* fout, float scale, const float* part) {
    const int tid = threadIdx.x, lane = tid & 63, wid = tid >> 6;
    LAS float* red = (LAS float*)lds;
    for (int rl = blockIdx.x; rl < 256; rl += gridDim.x) {
        const int pn = wid, row = M - 256 + rl, col = pn * 256 + lane * 4;
        f32x4 pv[NS];
#pragma unroll
        for (int sl = 0; sl < NS; ++sl) pv[sl] = *(const f32x4*)(part + ((size_t)(pn * NS + sl) * 256 + rl) * 256 + lane * 4);
        const u32x2 hv = *(const u32x2*)(hb + (size_t)row * D + col);
        f32x4 s = {0.f, 0.f, 0.f, 0.f};
#pragma unroll
        for (int sl = 0; sl < NS; ++sl) s += pv[sl];
        f32x4 h = {bflo(hv.x), bfhi(hv.x), bflo(hv.y), bfhi(hv.y)}; h += s * scale;
        if (fout) { const int b = row / T, t = row - b * T; if (t >= NMETA) *(f32x4*)(fout + ((size_t)b * SEQ + (t - NMETA)) * D + col) = h; }
        else { u32x2 w; w.x = cvt_pk_bf16(h[0], h[1]); w.y = cvt_pk_bf16(h[2], h[3]); *(u32x2*)(hb + (size_t)row * D + col) = w;
            float ss = (h[0] * h[0] + h[1] * h[1]) + (h[2] * h[2] + h[3] * h[3]); ss = wave_sum(ss);
            __syncthreads(); if (lane == 0) red[wid] = ss; __syncthreads();
            if (tid == 0) { const float tot = ((red[0] + red[1]) + (red[2] + red[3])) + ((red[4] + red[5]) + (red[6] + red[7])); rstd_next[row] = __builtin_amdgcn_rsqf(tot * (1.0f / D) + EPS); } }
    }
    if (!fout) for (int r = blockIdx.x * NTHREADS + tid; r < M - 256; r += gridDim.x * NTHREADS) {
        const f32x4* p = (const f32x4*)(ssq_next + (size_t)r * 32); float s = 0.f;
#pragma unroll
        for (int i = 0; i < 8; ++i) { const f32x4 v = p[i]; s += (v[0] + v[1]) + (v[2] + v[3]); }
        rstd_next[r] = __builtin_amdgcn_rsqf(s * (1.0f / D) + EPS);
    }
}
__device__ __forceinline__ void mlstm_y_phase(bf16_t* P, const float* g_head) {
    const int tid = threadIdx.x, lane = tid & 63, wid = tid >> 6;
    const int gw = blockIdx.x * 8 + wid, NGW = gridDim.x * 8;
    for (int it0 = gw * 4; it0 < M * 4; it0 += NGW * 4) {
        const int row = it0 >> 2; bf16_t* base = P + (size_t)row * MINP + lane * 8;
        u32x4 hv[4], ov[4];
#pragma unroll
        for (int h = 0; h < 4; ++h) { hv[h] = *(const u32x4*)(base + 2048 + h * 512); ov[h] = *(const u32x4*)(base + 4096 + h * 512); }
        float ss[4];
#pragma unroll
        for (int h = 0; h < 4; ++h) { const float a0 = bflo(hv[h].x), a1 = bfhi(hv[h].x), a2 = bflo(hv[h].y), a3 = bfhi(hv[h].y), a4 = bflo(hv[h].z), a5 = bfhi(hv[h].z), a6 = bflo(hv[h].w), a7 = bfhi(hv[h].w);
            ss[h] = (a0 * a0 + a1 * a1) + (a2 * a2 + a3 * a3) + (a4 * a4 + a5 * a5) + (a6 * a6 + a7 * a7); }
#pragma unroll
        for (int o = 1; o < 64; o <<= 1) {
#pragma unroll
            for (int h = 0; h < 4; ++h) ss[h] += __shfl_xor(ss[h], o); }
#pragma unroll
        for (int h = 0; h < 4; ++h) {
            const float rs = __builtin_amdgcn_rsqf(ss[h] * (1.0f / 512.0f) + EPS);
            float x[8] = {bflo(hv[h].x), bfhi(hv[h].x), bflo(hv[h].y), bfhi(hv[h].y), bflo(hv[h].z), bfhi(hv[h].z), bflo(hv[h].w), bfhi(hv[h].w)};
            const float o[8] = {bflo(ov[h].x), bfhi(ov[h].x), bflo(ov[h].y), bfhi(ov[h].y), bflo(ov[h].z), bfhi(ov[h].z), bflo(ov[h].w), bfhi(ov[h].w)};
            const f32x4 g0 = *(const f32x4*)(g_head + h * 512 + lane * 8), g1 = *(const f32x4*)(g_head + h * 512 + lane * 8 + 4);
            const float g[8] = {g0[0], g0[1], g0[2], g0[3], g1[0], g1[1], g1[2], g1[3]};
#pragma unroll
            for (int i = 0; i < 8; ++i) x[i] = x[i] * rs * g[i] * __builtin_amdgcn_rcpf(1.0f + __builtin_amdgcn_exp2f(-1.4426950408889634f * o[i]));
            u32x4 w; w.x = cvt_pk_bf16(x[0], x[1]); w.y = cvt_pk_bf16(x[2], x[3]); w.z = cvt_pk_bf16(x[4], x[5]); w.w = cvt_pk_bf16(x[6], x[7]);
            *(u32x4*)(base + 2048 + h * 512) = w;
        }
    }
}
__device__ __forceinline__ float rope_inv(int i) {
    constexpr float tab[16] = {1.000000000e+00f, 4.403665960e-01f, 1.939227432e-01f, 8.539710194e-02f, 3.760603070e-02f, 1.656044088e-02f, 7.292664610e-03f, 3.211446106e-03f,
                               1.414213562e-03f, 6.227724371e-04f, 2.742481884e-04f, 1.207697351e-04f, 5.318295734e-05f, 2.341999971e-05f, 1.031338525e-05f, 4.541670478e-06f};
    return tab[i];
}
template <int DPL>
__device__ __forceinline__ void rope_ld(const bf16_t* ptr, bool active, u32x4 (&raw)[DPL / 8]) {
#pragma unroll
    for (int i = 0; i < DPL / 8; ++i) { raw[i] = (u32x4){0u, 0u, 0u, 0u}; if (active) raw[i] = *(const u32x4*)(ptr + 8 * i); }
}
template <int DPL, bool NORM>
__device__ __forceinline__ void rope_apply(const u32x4 (&raw)[DPL / 8], bf16_t* ptr, bool active, const float* gain, float post, float pos, int quarter) {
    float x[DPL];
#pragma unroll
    for (int i = 0; i < DPL / 8; ++i) { const u32x4 v = raw[i];
        x[8 * i + 0] = bflo(v.x); x[8 * i + 1] = bfhi(v.x); x[8 * i + 2] = bflo(v.y); x[8 * i + 3] = bfhi(v.y); x[8 * i + 4] = bflo(v.z); x[8 * i + 5] = bfhi(v.z); x[8 * i + 6] = bflo(v.w); x[8 * i + 7] = bfhi(v.w); }
    if (NORM) { float ss = 0.f;
#pragma unroll
        for (int i = 0; i < DPL; ++i) ss += x[i] * x[i];
        ss += __shfl_xor(ss, 1); ss += __shfl_xor(ss, 2); const float rs = __builtin_amdgcn_rsqf(ss * (1.0f / (4 * DPL)) + EPS);
#pragma unroll
        for (int i = 0; i < DPL / 4; ++i) { const f32x4 g = *(const f32x4*)(gain + 4 * i); x[4 * i] *= rs * g[0]; x[4 * i + 1] *= rs * g[1]; x[4 * i + 2] *= rs * g[2]; x[4 * i + 3] *= rs * g[3]; } }
    if (quarter == 0) {
#pragma unroll
        for (int i = 0; i < DPL / 2; ++i) { const float ang = pos * rope_inv(i * (32 / DPL)); const float n = rintf(ang * 0.15915494309189535f);
            float r = fmaf(-n, 6.28125f, ang); r = fmaf(-n, 1.9353071795864769e-3f, r); const float sn = __sinf(r), cs = __cosf(r);
            const float x1 = x[i], x2 = x[i + DPL / 2]; x[i] = x1 * cs - x2 * sn; x[i + DPL / 2] = x2 * cs + x1 * sn; } }
    if (active) {
#pragma unroll
        for (int i = 0; i < DPL / 8; ++i) { u32x4 w; w.x = cvt_pk_bf16(x[8 * i] * post, x[8 * i + 1] * post); w.y = cvt_pk_bf16(x[8 * i + 2] * post, x[8 * i + 3] * post);
            w.z = cvt_pk_bf16(x[8 * i + 4] * post, x[8 * i + 5] * post); w.w = cvt_pk_bf16(x[8 * i + 6] * post, x[8 * i + 7] * post); *(u32x4*)(ptr + 8 * i) = w; } }
}
__device__ __forceinline__ void dsa_post_phase(bf16_t* P, bf16_t* vT, bf16_t* kiC, const float* g_q, const float* g_k) {
    const int tid = threadIdx.x, lane = tid & 63, wid = tid >> 6, head = lane >> 2, quarter = lane & 3;
    const int gw = blockIdx.x * 8 + wid, NGW = gridDim.x * 8;
    for (int unit = blockIdx.x; unit < NB * 33; unit += gridDim.x) {
        const int b = unit / 33, tile = unit - b * 33, t0 = tile * 64;
        const int gd = tid, g = gd >> 7, d = gd & 127; bf16_t* dst = vT + ((size_t)(b * 4 + g) * 128 + d) * TP + t0;
#pragma unroll
        for (int l8 = 0; l8 < 8; ++l8) { unsigned short v[8];
#pragma unroll
            for (int e = 0; e < 8; ++e) { const int t = t0 + 8 * l8 + e; v[e] = t < T ? P[((size_t)b * T + t) * AINP + 2560 + gd] : (unsigned short)0; }
            u32x4 w; w.x = v[0] | ((unsigned)v[1] << 16); w.y = v[2] | ((unsigned)v[3] << 16); w.z = v[4] | ((unsigned)v[5] << 16); w.w = v[6] | ((unsigned)v[7] << 16);
            *(u32x4*)(dst + 8 * l8) = w; }
    }
    for (int r = gw; r < M; r += NGW) {
        const int b = r / T, t = r - b * T; bf16_t* base = P + (size_t)r * AINP; const float pos = (float)t;
        bf16_t* pq = base + head * 128 + quarter * 32; bf16_t* pk = base + 2048 + (head & 3) * 128 + quarter * 32; bf16_t* pqi = base + 3072 + head * 64 + quarter * 16; bf16_t* pki = base + 4096 + quarter * 16;
        u32x4 rq[4], rk[4], rqi[2], rki[2];
        rope_ld<32>(pq, true, rq); rope_ld<32>(pk, lane < 16, rk); rope_ld<16>(pqi, true, rqi); rope_ld<16>(pki, lane < 4, rki);
        const unsigned short wraw = lane < 16 ? base[4160 + lane] : (unsigned short)0;
        rope_apply<32, true>(rq, pq, true, g_q + quarter * 32, 0.08838834764831845f * 1.4426950408889634f, pos, quarter);
        rope_apply<32, true>(rk, pk, lane < 16, g_k + quarter * 32, 1.0f, pos, quarter);
        rope_apply<16, false>(rqi, pqi, true, nullptr, 1.0f, pos, quarter);
        rope_apply<16, false>(rki, kiC + (size_t)r * 64 + quarter * 16, lane < 4, nullptr, 1.0f, pos, quarter);
        if (lane < 16) base[4160 + lane] = f2bf1(bf2f(wraw) * 0.03125f);
    }
}
__device__ __forceinline__ unsigned wave_count(int c) {
#pragma unroll
    for (int o = 1; o < 64; o <<= 1) c += __shfl_xor(c, o);
    return (unsigned)c;
}
constexpr int TK_SC = 0, TK_KB = 69632, TK_KBUF = 18432;
__device__ __forceinline__ void dsa_topk_phase(LAS unsigned char* lds, const bf16_t* P, const bf16_t* kiC, unsigned* mask) {
    const int tid = threadIdx.x, lane = tid & 63, wid = __builtin_amdgcn_readfirstlane(tid >> 6), fr = lane & 15, fq = lane >> 4;
    LAS float* sc = (LAS float*)(lds + TK_SC + wid * 8704);
    for (int unit = blockIdx.x; unit < NB * 258; unit += gridDim.x) {
        const int g8 = 257 - unit / NB, b = unit % NB;
        const int t = 8 * g8 + wid; const size_t row = (size_t)b * T + t; const bf16_t* base = P + row * AINP;
        if (8 * g8 + 7 < 256) {
            unsigned long long* mr = (unsigned long long*)(mask + row * 66);
#pragma unroll
            for (int c = 0; c < 33; ++c) { const unsigned long long bal = __ballot(64 * c + lane <= t); if (lane == 0) mr[c] = bal; }
            continue;
        }
        const bf16x8 A0 = *(const bf16x8*)(base + 3072 + fr * 64 + fq * 8), A1 = *(const bf16x8*)(base + 3072 + fr * 64 + 32 + fq * 8);
        const u32x2 wv = *(const u32x2*)(base + 4160 + fq * 4); const bf16x4 Wf = __builtin_bit_cast(bf16x4, wv);
        const int nk8 = ((8 * g8 + 7) >> 7) + 1;
        u32x4 pf[2];
#define TK_FETCH(k8_) do { _Pragma("unroll") for (int i = 0; i < 2; ++i) { const int ch = tid + 512 * i; int key = 128 * (k8_) + (ch >> 3); key = key < T ? key : T - 1; \
            pf[i] = *(const u32x4*)(kiC + ((size_t)b * T + key) * 64 + (ch & 7) * 8); } } while (0)
#define TK_PUT(buf_) do { _Pragma("unroll") for (int i = 0; i < 2; ++i) { const int ch = tid + 512 * i; *(LAS u32x4*)(lds + TK_KB + (buf_) * TK_KBUF + (ch >> 3) * 144 + (ch & 7) * 16) = pf[i]; } } while (0)
        __syncthreads();
        TK_FETCH(0); TK_PUT(0);
        __syncthreads();
        for (int k8 = 0; k8 < nk8; ++k8) {
            const LAS unsigned char* kb = lds + TK_KB + (k8 & 1) * TK_KBUF + fr * 144 + fq * 16;
            if (k8 + 1 < nk8) TK_FETCH(k8 + 1);
            float v[8];
#pragma unroll
            for (int i = 0; i < 8; ++i) { const bf16x8 B0 = *(const LAS bf16x8*)(kb + i * 16 * 144), B1 = *(const LAS bf16x8*)(kb + i * 16 * 144 + 64);
                f32x4 acc = {0.f, 0.f, 0.f, 0.f}; acc = mfma16(A0, B0, acc); acc = mfma16(A1, B1, acc);
                const float inf = __builtin_inff(); u32x2 pw;
                pw.x = cvt_pk_bf16(__builtin_amdgcn_fmed3f(acc[0], 0.f, inf), __builtin_amdgcn_fmed3f(acc[1], 0.f, inf)); pw.y = cvt_pk_bf16(__builtin_amdgcn_fmed3f(acc[2], 0.f, inf), __builtin_amdgcn_fmed3f(acc[3], 0.f, inf));
                const f32x4 d = __builtin_amdgcn_mfma_f32_16x16x16bf16_1k(Wf, __builtin_bit_cast(bf16x4, pw), (f32x4){0.f, 0.f, 0.f, 0.f}, 0, 0, 0);
                v[i] = d[0]; }
            sc[128 * k8 + lane] = fq == 0 ? v[0] : (fq == 1 ? v[1] : (fq == 2 ? v[2] : v[3]));
            sc[128 * k8 + 64 + lane] = fq == 0 ? v[4] : (fq == 1 ? v[5] : (fq == 2 ? v[6] : v[7]));
            if (k8 + 1 < nk8) TK_PUT((k8 + 1) & 1);
            __syncthreads();
        }
#undef TK_FETCH
#undef TK_PUT
        unsigned u[33];
#pragma unroll
        for (int c = 0; c < 33; ++c) { const int key = 64 * c + lane; unsigned bits = 0u;
            if (key <= t) { const unsigned f = __builtin_bit_cast(unsigned, sc[key]); bits = (f & 0x80000000u) ? ~f : (f | 0x80000000u); }
            u[c] = bits; }
        unsigned long long* mrow = (unsigned long long*)(mask + row * 66);
        if (t < 256) {
#pragma unroll
            for (int c = 0; c < 33; ++c) { const unsigned long long bal = __ballot(64 * c + lane <= t); if (lane == 0) mrow[c] = bal; }
        } else {
            unsigned th = 0u; bool exact = false;
            for (int bit = 31; bit >= 0; --bit) { const unsigned cand = th | (1u << bit); unsigned cnt = 0u;
#pragma unroll
                for (int c = 0; c < 33; ++c) cnt += (unsigned)__popcll(__ballot(u[c] >= cand));
                if (cnt >= 256u) { th = cand; if (cnt == 256u) { exact = true; break; } } }
            unsigned need = 0u;
            if (!exact) { unsigned cgt = 0u;
#pragma unroll
                for (int c = 0; c < 33; ++c) cgt += (unsigned)__popcll(__ballot(u[c] > th));
                need = 256u - cgt; }
            unsigned seen = 0u;
            const unsigned long long lt_mask = (1ull << lane) - 1ull;
#pragma unroll
            for (int c = 0; c < 33; ++c) { const bool eq = !exact && (u[c] == th), gt = exact ? (u[c] >= th) : (u[c] > th); const unsigned long long beq = __ballot(eq);
                const unsigned rank = seen + (unsigned)__popcll(beq & lt_mask); const bool sel = gt || (eq && rank < need);
                seen += (unsigned)__popcll(beq); const unsigned long long bal = __ballot(sel); if (lane == 0) mrow[c] = bal; }
        }
    }
}
constexpr int AT_K = 0, AT_V = 17408, AT_BUF = 35840;
__device__ __forceinline__ void dsa_attn_phase(LAS unsigned char* lds, const bf16_t* P, bf16_t* Oout, int ldo, const bf16_t* vT, const unsigned* mask) {
    const int tid = threadIdx.x, lane = tid & 63, wid = __builtin_amdgcn_readfirstlane(tid >> 6), fr = lane & 15, fq = lane >> 4;
    const int qt = wid & 3, rp = wid >> 2;
    for (int unit = blockIdx.x; unit < 33 * 64; unit += gridDim.x) {
        const int qb = 32 - unit / 64, bg = unit % 64, b = bg >> 2, g = bg & 3;
        const int tq = 64 * qb + 16 * qt + fr, tqc = tq < T ? tq : T - 1; const size_t rowq = (size_t)b * T + tqc;
        bf16x8 Qf[2][4];
#pragma unroll
        for (int hh = 0; hh < 2; ++hh)
#pragma unroll
            for (int ks = 0; ks < 4; ++ks) Qf[hh][ks] = *(const bf16x8*)(P + rowq * AINP + (g * 4 + rp * 2 + hh) * 128 + 32 * ks + fq * 8);
        f32x4 O[8][2];
#pragma unroll
        for (int dt = 0; dt < 8; ++dt) { O[dt][0] = (f32x4){0.f, 0.f, 0.f, 0.f}; O[dt][1] = (f32x4){0.f, 0.f, 0.f, 0.f}; }
        float mx[2] = {-1e30f, -1e30f}, ls[2] = {0.f, 0.f};
        const unsigned long long* mrow = (const unsigned long long*)(mask + rowq * 66);
        u32x4 pk[2], pv[2];
#define AT_FETCH(kt_) do { _Pragma("unroll") for (int i = 0; i < 2; ++i) { const int ch = tid + 512 * i; { const int l = ch >> 4, cc = ch & 15; int key = 64 * (kt_) + l; key = key < T ? key : T - 1; \
            pk[i] = *(const u32x4*)(P + ((size_t)b * T + key) * AINP + 2048 + g * 128 + cc * 8); } \
            { const int d = ch >> 3, cc = ch & 7; pv[i] = *(const u32x4*)(vT + ((size_t)(b * 4 + g) * 128 + d) * TP + 64 * (kt_) + cc * 8); } } } while (0)
#define AT_PUT(buf_) do { _Pragma("unroll") for (int i = 0; i < 2; ++i) { const int ch = tid + 512 * i; *(LAS u32x4*)(lds + (buf_) * AT_BUF + AT_K + (ch >> 4) * 272 + (ch & 15) * 16) = pk[i]; \
            *(LAS u32x4*)(lds + (buf_) * AT_BUF + AT_V + (ch >> 3) * 144 + (ch & 7) * 16) = pv[i]; } } while (0)
        __syncthreads();
        AT_FETCH(0); AT_PUT(0);
        unsigned long long mw_next = mrow[0];
        __syncthreads();
        for (int kt64 = 0; kt64 <= qb; ++kt64) {
            const LAS unsigned char* lb = lds + (kt64 & 1) * AT_BUF;
            const unsigned long long mw = mw_next;
            if (kt64 < qb) { AT_FETCH(kt64 + 1); mw_next = mrow[kt64 + 1]; }
            f32x4 S[2][4];
#pragma unroll
            for (int kt = 0; kt < 4; ++kt) { S[0][kt] = (f32x4){0.f, 0.f, 0.f, 0.f}; S[1][kt] = (f32x4){0.f, 0.f, 0.f, 0.f};
#pragma unroll
                for (int ks = 0; ks < 4; ++ks) { const bf16x8 A = *(const LAS bf16x8*)(lb + AT_K + (16 * kt + fr) * 272 + (32 * ks + fq * 8) * 2);
                    S[0][kt] = mfma16(A, Qf[0][ks], S[0][kt]); S[1][kt] = mfma16(A, Qf[1][ks], S[1][kt]); } }
            bf16x8 Pf[2][2]; float alpha[2];
#pragma unroll
            for (int hh = 0; hh < 2; ++hh) {
                float tmax = -__builtin_inff();
#pragma unroll
                for (int kt = 0; kt < 4; ++kt)
#pragma unroll
                    for (int j = 0; j < 4; ++j) { const bool bit = (mw >> (16 * kt + fq * 4 + j)) & 1ull; S[hh][kt][j] = bit ? S[hh][kt][j] : -__builtin_inff(); tmax = fmaxf(tmax, S[hh][kt][j]); }
                tmax = fmaxf(tmax, __shfl_xor(tmax, 16)); tmax = fmaxf(tmax, __shfl_xor(tmax, 32));
                const float mnew = fmaxf(mx[hh], tmax); alpha[hh] = __builtin_amdgcn_exp2f(mx[hh] - mnew); mx[hh] = mnew;
                float psum = 0.f;
#pragma unroll
                for (int kt = 0; kt < 4; ++kt)
#pragma unroll
                    for (int j = 0; j < 4; ++j) { S[hh][kt][j] = __builtin_amdgcn_exp2f(S[hh][kt][j] - mnew); psum += S[hh][kt][j]; }
                ls[hh] = ls[hh] * alpha[hh] + psum;
#pragma unroll
                for (int kk = 0; kk < 2; ++kk) { u32x4 w; w.x = cvt_pk_bf16(S[hh][2 * kk][0], S[hh][2 * kk][1]); w.y = cvt_pk_bf16(S[hh][2 * kk][2], S[hh][2 * kk][3]);
                    w.z = cvt_pk_bf16(S[hh][2 * kk + 1][0], S[hh][2 * kk + 1][1]); w.w = cvt_pk_bf16(S[hh][2 * kk + 1][2], S[hh][2 * kk + 1][3]); Pf[hh][kk] = __builtin_bit_cast(bf16x8, w); }
            }
#pragma unroll
            for (int dt = 0; dt < 8; ++dt) { O[dt][0] *= alpha[0]; O[dt][1] *= alpha[1];
#pragma unroll
                for (int kk = 0; kk < 2; ++kk) { const LAS unsigned char* vp = lb + AT_V + (16 * dt + fr) * 144 + (32 * kk + fq * 4) * 2;
                    const bf16x8 A = cat8(*(const LAS u32x2*)vp, *(const LAS u32x2*)(vp + 32));
                    O[dt][0] = mfma16(A, Pf[0][kk], O[dt][0]); O[dt][1] = mfma16(A, Pf[1][kk], O[dt][1]); } }
            if (kt64 < qb) AT_PUT((kt64 + 1) & 1);
            __syncthreads();
        }
#undef AT_FETCH
#undef AT_PUT
#pragma unroll
        for (int hh = 0; hh < 2; ++hh) { float l = ls[hh]; l += __shfl_xor(l, 16); l += __shfl_xor(l, 32); const float inv = 1.0f / l;
            if (tq < T) {
#pragma unroll
                for (int dt = 0; dt < 8; ++dt) { u32x2 w; w.x = cvt_pk_bf16(O[dt][hh][0] * inv, O[dt][hh][1] * inv); w.y = cvt_pk_bf16(O[dt][hh][2] * inv, O[dt][hh][3] * inv);
                    *(u32x2*)(Oout + rowq * ldo + (g * 4 + rp * 2 + hh) * 128 + 16 * dt + fq * 4) = w; } } }
    }
}
constexpr int N_PHASES = 18;
__global__ void __launch_bounds__(NTHREADS, 2) mega_fwd(Args a) {
    extern __shared__ __attribute__((aligned(16))) unsigned char lds_raw[];
    LAS unsigned char* lds = (LAS unsigned char*)lds_raw;
    cg::grid_group grid = cg::this_grid();
    volatile LAS unsigned* bst = (volatile LAS unsigned*)(lds + LDS_BYTES - 64);
    if (threadIdx.x == 0) { bst[0] = 0u; bst[1] = 0u; }
    __syncthreads();
    const XcdBarrier xbar = xcd_barrier_post((unsigned*)(a.ws + WS_BAR), bst);
    unsigned char* ws = a.ws;
    bf16_t* hb = (bf16_t*)(ws + WS_HB); bf16_t* P = (bf16_t*)(ws + WS_P); float* ssq = (float*)(ws + WS_SSQ); float* rstd = (float*)(ws + WS_RSTD);
    unsigned* mask = (unsigned*)(ws + WS_MASK); bf16_t* vT = (bf16_t*)(ws + WS_VT); float* part = (float*)(ws + WS_PART); bf16_t* kiC = (bf16_t*)(ws + WS_KIC);
    const int lo = a.ph_lo, hi = a.ph_hi;
    const int G = (int)gridDim.x, cidx = (int)blockIdx.x;
#ifndef PHMASK
#define PHMASK 0x3ffff
#endif
#define IN(k) ((((PHMASK) >> (k)) & 1) && lo <= (k) && (k) < hi)
#define GSYNC() xcd_barrier(xbar)
#define SEAM(k) do { if (IN(k) && IN((k) + 1)) GSYNC(); } while (0)
#define GEMM_GU(k, f, sidx) if (IN(k)) { pg8::Gemm g{hb, (const bf16_t*)(ws + WS_GU + (size_t)(f) * SZ_GU), M, 2 * FF, D, D}; pg8::StaticOrder S; S.init(M, 2 * FF, D, G, cidx); \
        pg8::EpiSwiglu E{P, rstd + (size_t)(sidx) * M}; pg8::gemm_phase<pg8::EpiSwiglu, pg8::StaticOrder, true, true>(lds, g, S, E); } SEAM(k)
#define GEMM_DN(k, f, snext) if (IN(k)) { pg8::Gemm g{P, (const bf16_t*)(ws + WS_DN + (size_t)(f) * SZ_DN), M, D, FF, FF}; pg8::TailOrder S; S.init(M, D, FF, 22, G, cidx); \
        float* sn_ = ssq + (size_t)((snext) >= 0 ? (snext) : 0) * M * 32; float* fo_ = (snext) >= 0 ? nullptr : a.out; \
        pg8::EpiResid E{hb, sn_, fo_, 0.5f, part, 22}; pg8::gemm_phase<pg8::EpiResid, pg8::TailOrder, true, true>(lds, g, S, E); \
        GSYNC(); tail_fixup_phase<22>(lds, hb, sn_, rstd + (size_t)((snext) >= 0 ? (snext) : 0) * M, fo_, 0.5f, part); } SEAM(k)
#define GEMM_OUT(k, Aptr, lda_, Wofs, sidx) if (IN(k)) { pg8::Gemm g{Aptr, (const bf16_t*)(ws + (Wofs)), M, D, D, lda_}; pg8::TailOrder S; S.init(M, D, D, 16, G, cidx); \
        float* sn_ = ssq + (size_t)(sidx) * M * 32; \
        pg8::EpiResid E{hb, sn_, nullptr, 1.0f, part, 16}; pg8::gemm_phase<pg8::EpiResid, pg8::TailOrder, true, true>(lds, g, S, E); \
        GSYNC(); tail_fixup_phase<16>(lds, hb, sn_, rstd + (size_t)(sidx) * M, nullptr, 1.0f, part); } SEAM(k)

    if (IN(0)) prologue_phase(lds, a);
#ifdef DUP_PRO
    if (IN(0)) { __syncthreads(); prologue_phase(lds, a); }
#endif
    if (IN(0) && IN(1)) grid.sync();
#ifdef DUP_SYNC
    for (int i_ = 0; i_ < 20; ++i_) GSYNC();
#endif
    GEMM_GU(1, 0, 0);
    GEMM_DN(2, 0, 1);
    if (IN(3)) { pg8::Gemm g{hb, (const bf16_t*)(ws + WS_MIN), M, MINP, D, D}; pg8::StaticOrder S; S.init(M, MINP, D, G, cidx);
        pg8::EpiRowScale E{P, MINP, rstd + (size_t)1 * M}; pg8::gemm_phase<pg8::EpiRowScale, pg8::StaticOrder, true, true>(lds, g, S, E); }
    SEAM(3);
#ifdef DUP_SCAN
    if (IN(4)) { mlstm_scan_phase(lds, P, hb, D, a.in[12], a.in[13]); __syncthreads(); }
#endif
    if (IN(4)) mlstm_scan_phase(lds, P, P + 2048, MINP, a.in[12], a.in[13]);
    SEAM(4);
    if (IN(5)) mlstm_y_phase(P, a.in[14]);
    SEAM(5);
    GEMM_OUT(6, P + 2048, MINP, WS_MOUT, 2);
    GEMM_GU(7, 1, 2);
    GEMM_DN(8, 1, 3);
    GEMM_GU(9, 2, 3);
    GEMM_DN(10, 2, 4);
    if (IN(11)) { pg8::Gemm g{hb, (const bf16_t*)(ws + WS_AIN), M, AINP, D, D}; pg8::StaticOrder S; S.init(M, AINP, D, G, cidx);
        pg8::EpiRowScale E{P, AINP, rstd + (size_t)4 * M}; pg8::gemm_phase<pg8::EpiRowScale, pg8::StaticOrder, true, true>(lds, g, S, E); }
    SEAM(11);
    if (IN(12)) dsa_post_phase(P, vT, kiC, a.in[17], a.in[18]);
    SEAM(12);
    if (IN(13)) dsa_topk_phase(lds, P, kiC, mask);
#ifdef DUP_TOPK
    if (IN(13)) { __syncthreads(); dsa_topk_phase(lds, P, kiC, mask); }
#endif
    SEAM(13);
#ifdef DUP_ATTN
    if (IN(14)) { dsa_attn_phase(lds, P, hb, D, vT, mask); __syncthreads(); }
#endif
    if (IN(14)) dsa_attn_phase(lds, P, P, AINP, vT, mask);
    SEAM(14);
    GEMM_OUT(15, P, AINP, WS_AOUT, 5);
    GEMM_GU(16, 3, 5);
    GEMM_DN(17, 3, -1);
#undef IN
#undef SEAM
}

extern "C" void kernel_launch(void* const* d_in, const int* in_sizes, int n_in, void* d_out, int out_size, void* d_ws, size_t ws_size, hipStream_t stream) {
    static int grid = 0;
    if (grid == 0) {
        if (n_in != 20 || out_size != NB * SEQ * D || ws_size < WS_END) { fprintf(stderr, "kernel_launch: unexpected problem: n_in %d out %d ws %zu (need %zu)\n", n_in, out_size, ws_size, (size_t)WS_END); grid = -1; return; }
        int dev = 0, cus = 0, per_cu = 0;
        if (hipGetDevice(&dev) != hipSuccess || hipDeviceGetAttribute(&cus, hipDeviceAttributeMultiprocessorCount, dev) != hipSuccess) { fprintf(stderr, "kernel_launch: device query failed\n"); grid = -1; return; }
        if (hipFuncSetAttribute((const void*)mega_fwd, hipFuncAttributeMaxDynamicSharedMemorySize, LDS_BYTES) != hipSuccess) { fprintf(stderr, "kernel_launch: hipFuncSetAttribute failed\n"); grid = -1; return; }
        if (hipOccupancyMaxActiveBlocksPerMultiprocessor(&per_cu, (const void*)mega_fwd, NTHREADS, LDS_BYTES) != hipSuccess || per_cu < 1) { fprintf(stderr, "kernel_launch: occupancy query gave %d\n", per_cu); per_cu = 1; }
        (void)hipGetLastError();
        grid = cus;
    }
    if (grid < 0) return;
    if (hipMemsetAsync((char*)d_ws + WS_BAR, 0, 16384, stream) != hipSuccess) { fprintf(stderr, "kernel_launch: memset of the barrier words failed\n"); return; }
    Args a{};
    for (int i = 0; i < 20; ++i) a.in[i] = (const float*)d_in[i];
    a.out = (float*)d_out; a.ws = (unsigned char*)d_ws;
    a.ph_lo = 0; a.ph_hi = N_PHASES;
    void* args[] = {&a};
    const hipError_t e = hipLaunchCooperativeKernel((const void*)mega_fwd, dim3(grid), dim3(NTHREADS), args, LDS_BYTES, stream);
    if (e != hipSuccess) fprintf(stderr, "kernel_launch: cooperative launch failed: %s (grid %d)\n", hipGetErrorString(e), grid);
}
```
